# Optimizing an MI355X kernel written in HIP

```python
import math
import jax
import jax.numpy as jnp
from jax import lax
import numpy as np

D_MODEL = 2048
BATCH = 1
SEQ = 16384
DEPTH = 2

EPS = 1e-6
MIX_WIDTH = D_MODEL
S5_WIDTH = MIX_WIDTH // 2
S5_GROUP = 16
S5_GROUPS = S5_WIDTH // S5_GROUP
S5_STATE = 64
S5_DT_MIN = 1e-3
S5_DT_MAX = 1e-1
GDN_HEAD_DIM = 128
GDN_V_HEADS = (MIX_WIDTH - S5_WIDTH) // GDN_HEAD_DIM
GDN_QK_HEADS = GDN_V_HEADS // 2
GDN_QK_W = GDN_QK_HEADS * GDN_HEAD_DIM
GDN_V_W = GDN_V_HEADS * GDN_HEAD_DIM
GDN_CONV = 4
GDN_CHUNK = 64
GLA_HEADS = 4
GLA_DK = MIX_WIDTH // 2
GLA_DV = MIX_WIDTH
GLA_LOWRANK = 16
GLA_TAU = 16.0
GLA_CHUNK = 64
FFN_HIDDEN = ((8 * D_MODEL // 3 + 255) // 256) * 256
IN0_SIZES = (S5_WIDTH, GDN_QK_W, GDN_QK_W, GDN_V_W, GDN_V_W, GDN_V_HEADS, GDN_V_HEADS)
IN1_SIZES = (GLA_DK, GLA_DK, GLA_DV, GLA_DV, GLA_LOWRANK)

kernel_name = "hybrid_s5_gdn_gla_sandwich_adaln"


def _split(y, sizes):
    points = np.cumsum(np.array(sizes))[:-1].tolist()
    return jnp.split(y, points, axis=-1)


def rmsnorm(x, w):
    xf = x.astype(jnp.float32)
    y = xf * lax.rsqrt(jnp.mean(xf * xf, axis=-1, keepdims=True) + EPS)
    return (y * w.astype(jnp.float32)).astype(x.dtype)


def l2norm(x):
    return x * lax.rsqrt(jnp.sum(x * x, axis=-1, keepdims=True) + EPS)


def ada_modulation(c, w, b):
    mod = jax.nn.silu(c) @ w + b
    return jnp.split(mod[:, None, :], 6, axis=-1)


def swiglu(h, w_gate, w_up, w_down):
    return (jax.nn.silu(h @ w_gate) * (h @ w_up)) @ w_down


def causal_dwconv(x, w):
    k = w.shape[0]
    return lax.conv_general_dilated(
        x, w[:, None, :].astype(x.dtype), window_strides=(1,), padding=((k - 1, 0),),
        dimension_numbers=("NWC", "WIO", "NWC"), feature_group_count=x.shape[-1])


def to_chunks(x, c):
    b, l, h = x.shape[:3]
    x = x.reshape((b, l // c, c, h) + x.shape[3:])
    return jnp.moveaxis(x, 3, 1)


def s5_mixer(u, lam_re, lam_im, log_step, b_re, b_im, c_re, c_im, d, glu_w, glu_b):
    f32 = jnp.float32
    bsz, l, _ = u.shape
    uf = u.astype(f32).reshape(bsz, l, S5_GROUPS, S5_GROUP)
    lr, li = lam_re.astype(f32), lam_im.astype(f32)
    dt = jnp.exp(log_step.astype(f32))[:, None]
    mag = jnp.exp(lr * dt)
    ab_re, ab_im = mag * jnp.cos(li * dt), mag * jnp.sin(li * dt)
    den = lr * lr + li * li
    nr, ni = ab_re - 1.0, ab_im
    f_re = (nr * lr + ni * li) / den
    f_im = (ni * lr - nr * li) / den
    br, bi = b_re.astype(f32), b_im.astype(f32)
    bb_re = f_re[..., None] * br - f_im[..., None] * bi
    bb_im = f_re[..., None] * bi + f_im[..., None] * br
    bu_re = jnp.einsum("blgp,gnp->blgn", uf, bb_re)
    bu_im = jnp.einsum("blgp,gnp->blgn", uf, bb_im)
    a_re = jnp.broadcast_to(ab_re, bu_re.shape)
    a_im = jnp.broadcast_to(ab_im, bu_im.shape)

    def combine(e1, e2):
        a1r, a1i, b1r, b1i = e1
        a2r, a2i, b2r, b2i = e2
        return (a2r * a1r - a2i * a1i, a2r * a1i + a2i * a1r,
                a2r * b1r - a2i * b1i + b2r, a2r * b1i + a2i * b1r + b2i)

    _, _, xr, xi = lax.associative_scan(combine, (a_re, a_im, bu_re, bu_im), axis=1)
    y = (jnp.einsum("blgn,gpn->blgp", xr, c_re.astype(f32))
         - jnp.einsum("blgn,gpn->blgp", xi, c_im.astype(f32))
         + d.astype(f32) * uf)
    y = jax.nn.gelu(y.reshape(bsz, l, S5_WIDTH)).astype(u.dtype)
    return y * jax.nn.sigmoid(y @ glu_w + glu_b)


def gated_delta_chunked(q, k, v, g, beta):
    bsz, l, h, _ = q.shape
    dv = v.shape[-1]
    cs = GDN_CHUNK
    q, k, v = to_chunks(q, cs), to_chunks(k, cs), to_chunks(v, cs)
    g = jnp.cumsum(to_chunks(g, cs), axis=-1)
    beta = to_chunks(beta, cs)
    causal = jnp.tril(jnp.ones((cs, cs), bool))
    strict = jnp.tril(jnp.ones((cs, cs), bool), -1)
    decay = jnp.exp(jnp.where(causal, g[..., :, None] - g[..., None, :], -jnp.inf))
    kb = k * beta[..., None]
    lower = jnp.where(strict, jnp.einsum("bhnid,bhnjd->bhnij", kb, k) * decay, 0.0)
    eye = jnp.eye(cs, dtype=q.dtype)
    t_mat = lax.linalg.triangular_solve(lower + eye, jnp.broadcast_to(eye, lower.shape),
                                        left_side=True, lower=True, unit_diagonal=True)
    u_vals = t_mat @ (v * beta[..., None])
    w_keys = t_mat @ (kb * jnp.exp(g)[..., None])
    attn = jnp.where(causal, jnp.einsum("bhnid,bhnjd->bhnij", q, k) * decay, 0.0)
    q_dec = q * jnp.exp(g)[..., None]
    k_dec = k * jnp.exp(g[..., -1:] - g)[..., None]
    g_last = jnp.exp(g[..., -1])
    xs = tuple(jnp.moveaxis(t, 2, 0) for t in (u_vals, w_keys, attn, q_dec, k_dec, g_last))

    def step(s, inp):
        u_c, w_c, a_c, qd, kd, gl = inp
        v_new = u_c - jnp.einsum("bhck,bhkv->bhcv", w_c, s)
        o_c = jnp.einsum("bhck,bhkv->bhcv", qd, s) + jnp.einsum("bhij,bhjv->bhiv", a_c, v_new)
        s = s * gl[..., None, None] + jnp.einsum("bhck,bhcv->bhkv", kd, v_new)
        return s, o_c

    s0 = jnp.zeros((bsz, h, q.shape[-1], dv), q.dtype)
    _, o = lax.scan(step, s0, xs)
    o = jnp.moveaxis(o, 0, 2)
    return o.transpose(0, 2, 3, 1, 4).reshape(bsz, l, h, dv)


def gdn_mixer(q, k, v, z, a, b, conv_w, a_log, dt_bias, norm_w):
    f32 = jnp.float32
    bsz, l, _ = q.shape
    qkv = jax.nn.silu(causal_dwconv(jnp.concatenate([q, k, v], axis=-1), conv_w)).astype(f32)
    q, k, v = _split(qkv, (GDN_QK_W, GDN_QK_W, GDN_V_W))
    rep = GDN_V_HEADS // GDN_QK_HEADS
    q = jnp.repeat(l2norm(q.reshape(bsz, l, GDN_QK_HEADS, GDN_HEAD_DIM)), rep, axis=2) * GDN_HEAD_DIM ** -0.5
    k = jnp.repeat(l2norm(k.reshape(bsz, l, GDN_QK_HEADS, GDN_HEAD_DIM)), rep, axis=2)
    v = v.reshape(bsz, l, GDN_V_HEADS, GDN_HEAD_DIM)
    beta = jax.nn.sigmoid(b.astype(f32))
    g = -jnp.exp(a_log.astype(f32)) * jax.nn.softplus(a.astype(f32) + dt_bias.astype(f32))
    o = gated_delta_chunked(q, k, v, g, beta)
    o = rmsnorm(o, norm_w) * jax.nn.silu(z.astype(f32).reshape(bsz, l, GDN_V_HEADS, GDN_HEAD_DIM))
    return o.reshape(bsz, l, GDN_V_W).astype(z.dtype)


def gla_chunked(q, k, v, gk):
    bsz, l, h, dk = q.shape
    dv = v.shape[-1]
    cs = GLA_CHUNK
    q, k, v, gk = (to_chunks(t, cs) for t in (q, k, v, gk))
    bcum = jnp.cumsum(gk, axis=3)
    q_t = q * jnp.exp(bcum)
    k_t = k * jnp.exp(-bcum)
    causal = jnp.tril(jnp.ones((cs, cs), bool))
    attn = jnp.where(causal, jnp.einsum("bhnik,bhnjk->bhnij", q_t, k_t), 0.0)
    o_intra = attn @ v
    k_dec = k * jnp.exp(bcum[..., -1:, :] - bcum)
    g_last = jnp.exp(bcum[..., -1, :])
    xs = tuple(jnp.moveaxis(t, 2, 0) for t in (q_t, k_dec, v, g_last))

    def step(s, inp):
        qt, kd, vc, gl = inp
        o_c = jnp.einsum("bhck,bhkv->bhcv", qt, s)
        s = s * gl[..., None] + jnp.einsum("bhck,bhcv->bhkv", kd, vc)
        return s, o_c

    s0 = jnp.zeros((bsz, h, dk, dv), q.dtype)
    _, o_inter = lax.scan(step, s0, xs)
    o = o_intra + jnp.moveaxis(o_inter, 0, 2)
    return o.transpose(0, 2, 3, 1, 4).reshape(bsz, l, h, dv)


def gla_mixer(q, k, v, r, g_low, gate_w2, gate_b, norm_w):
    f32 = jnp.float32
    bsz, l, _ = q.shape
    dk, dv = GLA_DK // GLA_HEADS, GLA_DV // GLA_HEADS
    gk = jax.nn.log_sigmoid((g_low @ gate_w2 + gate_b).astype(f32)) / GLA_TAU
    q = q.astype(f32).reshape(bsz, l, GLA_HEADS, dk) * dk ** -0.5
    k = k.astype(f32).reshape(bsz, l, GLA_HEADS, dk)
    v = v.astype(f32).reshape(bsz, l, GLA_HEADS, dv)
    gk = gk.reshape(bsz, l, GLA_HEADS, dk)
    o = gla_chunked(q, k, v, gk)
    o = rmsnorm(o, norm_w) * jax.nn.silu(r.astype(f32).reshape(bsz, l, GLA_HEADS, dv))
    return o.reshape(bsz, l, GLA_DV).astype(r.dtype)


def setup_inputs(seed: int = 0) -> dict:
    key = jax.random.key(seed)
    ks = iter(jax.random.split(key, 64))
    f32 = jnp.float32
    D = D_MODEL

    def nrm(shape, scale):
        return jax.random.normal(next(ks), shape, f32) * scale

    def unif(shape, lo, hi):
        return jax.random.uniform(next(ks), shape, f32, lo, hi)

    def gain(n):
        return 1.0 + nrm((n,), 0.02)

    inp = {}
    inp["x"] = nrm((BATCH, SEQ, D), 1.0)
    inp["c"] = nrm((BATCH, D), 1.0)
    inp["ada_w0"] = nrm((D, 6 * D), D ** -0.5)
    inp["ada_b0"] = nrm((6 * D,), 0.02)
    inp["mix_pre0"] = gain(D)
    inp["mix_post0"] = gain(D)
    inp["ffn_pre0"] = gain(D)
    inp["ffn_post0"] = gain(D)
    inp["w_in0"] = nrm((D, sum(IN0_SIZES)), D ** -0.5)
    n_idx = jnp.arange(S5_STATE, dtype=f32)[None, :]
    inp["s5_lambda_re"] = -0.5 + nrm((S5_GROUPS, S5_STATE), 0.01)
    inp["s5_lambda_im"] = math.pi * n_idx + nrm((S5_GROUPS, S5_STATE), 0.01)
    inp["s5_log_step"] = unif((S5_GROUPS,), math.log(S5_DT_MIN), math.log(S5_DT_MAX))
    inp["s5_b_re"] = nrm((S5_GROUPS, S5_STATE, S5_GROUP), (2 * S5_GROUP) ** -0.5)
    inp["s5_b_im"] = nrm((S5_GROUPS, S5_STATE, S5_GROUP), (2 * S5_GROUP) ** -0.5)
    inp["s5_c_re"] = nrm((S5_GROUPS, S5_GROUP, S5_STATE), (2 * S5_STATE) ** -0.5)
    inp["s5_c_im"] = nrm((S5_GROUPS, S5_GROUP, S5_STATE), (2 * S5_STATE) ** -0.5)
    inp["s5_d"] = nrm((S5_GROUPS, S5_GROUP), 0.5)
    inp["s5_glu_w"] = nrm((S5_WIDTH, S5_WIDTH), S5_WIDTH ** -0.5)
    inp["s5_glu_b"] = nrm((S5_WIDTH,), 0.02)
    inp["gdn_conv_w"] = nrm((GDN_CONV, 2 * GDN_QK_W + GDN_V_W), GDN_CONV ** -0.5)
    inp["gdn_a_log"] = jnp.log(unif((GDN_V_HEADS,), 1.0, 16.0))
    dt = jnp.exp(unif((GDN_V_HEADS,), math.log(1e-3), math.log(1e-1)))
    inp["gdn_dt_bias"] = dt + jnp.log(-jnp.expm1(-dt))
    inp["gdn_norm_w"] = gain(GDN_HEAD_DIM)
    inp["w_out0"] = nrm((MIX_WIDTH, D), MIX_WIDTH ** -0.5)
    inp["ffn_gate0"] = nrm((D, FFN_HIDDEN), D ** -0.5)
    inp["ffn_up0"] = nrm((D, FFN_HIDDEN), D ** -0.5)
    inp["ffn_down0"] = nrm((FFN_HIDDEN, D), FFN_HIDDEN ** -0.5)
    inp["ada_w1"] = nrm((D, 6 * D), D ** -0.5)
    inp["ada_b1"] = nrm((6 * D,), 0.02)
    inp["mix_pre1"] = gain(D)
    inp["mix_post1"] = gain(D)
    inp["ffn_pre1"] = gain(D)
    inp["ffn_post1"] = gain(D)
    inp["w_in1"] = nrm((D, sum(IN1_SIZES)), D ** -0.5)
    inp["gla_gate_w2"] = nrm((GLA_LOWRANK, GLA_DK), GLA_LOWRANK ** -0.5)
    inp["gla_gate_b"] = nrm((GLA_DK,), 0.1)
    inp["gla_norm_w"] = gain(GLA_DV // GLA_HEADS)
    inp["w_out1"] = nrm((GLA_DV, D), GLA_DV ** -0.5)
    inp["ffn_gate1"] = nrm((D, FFN_HIDDEN), D ** -0.5)
    inp["ffn_up1"] = nrm((D, FFN_HIDDEN), D ** -0.5)
    inp["ffn_down1"] = nrm((FFN_HIDDEN, D), FFN_HIDDEN ** -0.5)
    return inp


def reference(x, c, ada_w0, ada_b0, mix_pre0, mix_post0, ffn_pre0, ffn_post0, w_in0,
              s5_lambda_re, s5_lambda_im, s5_log_step, s5_b_re, s5_b_im, s5_c_re, s5_c_im,
              s5_d, s5_glu_w, s5_glu_b, gdn_conv_w, gdn_a_log, gdn_dt_bias, gdn_norm_w,
              w_out0, ffn_gate0, ffn_up0, ffn_down0,
              ada_w1, ada_b1, mix_pre1, mix_post1, ffn_pre1, ffn_post1, w_in1,
              gla_gate_w2, gla_gate_b, gla_norm_w, w_out1, ffn_gate1, ffn_up1, ffn_down1):

    def mixer_even(h):
        u, q, k, v, z, a, b = _split(h @ w_in0, IN0_SIZES)
        y_a = s5_mixer(u, s5_lambda_re, s5_lambda_im, s5_log_step, s5_b_re, s5_b_im,
                       s5_c_re, s5_c_im, s5_d, s5_glu_w, s5_glu_b)
        y_b = gdn_mixer(q, k, v, z, a, b, gdn_conv_w, gdn_a_log, gdn_dt_bias, gdn_norm_w)
        return jnp.concatenate([y_a, y_b.astype(y_a.dtype)], axis=-1) @ w_out0

    def mixer_odd(h):
        q, k, v, r, g_low = _split(h @ w_in1, IN1_SIZES)
        return gla_mixer(q, k, v, r, g_low, gla_gate_w2, gla_gate_b, gla_norm_w) @ w_out1

    layers = (
        (mixer_even, ada_w0, ada_b0, mix_pre0, mix_post0, ffn_pre0, ffn_post0, ffn_gate0, ffn_up0, ffn_down0),
        (mixer_odd, ada_w1, ada_b1, mix_pre1, mix_post1, ffn_pre1, ffn_post1, ffn_gate1, ffn_up1, ffn_down1),
    )
    for i in range(DEPTH):
        mixer, aw, ab, m_pre, m_post, f_pre, f_post, wg, wu, wd = layers[i]
        sh_m, sc_m, gt_m, sh_f, sc_f, gt_f = ada_modulation(c, aw, ab)
        h = rmsnorm(x, m_pre) * (1.0 + sc_m) + sh_m
        x = x + gt_m * rmsnorm(mixer(h), m_post)
        h = rmsnorm(x, f_pre) * (1.0 + sc_f) + sh_f
        x = x + gt_f * rmsnorm(swiglu(h, wg, wu, wd), f_post)
    return x
```

```cpp
#include <hip/hip_runtime.h>
#include <hip/hip_cooperative_groups.h>
#include <cstdio>
#include <cstdint>
namespace cg = cooperative_groups;

#ifndef MK_SINGLE_LAUNCH
#define MK_SINGLE_LAUNCH 1
#define M4LIST 0,0,0,0
#endif

#define LAS __attribute__((address_space(3)))
typedef unsigned short bf16_t;
typedef short bf16x8 __attribute__((ext_vector_type(8)));
typedef float f32x4 __attribute__((ext_vector_type(4)));
typedef float f32x2 __attribute__((ext_vector_type(2)));
typedef unsigned u32x4 __attribute__((ext_vector_type(4)));
typedef unsigned u32x2 __attribute__((ext_vector_type(2)));

constexpr int SEQ = 16384, DM = 2048, FFH = 5632;
constexpr int NPHASE = 20;
constexpr float EPS = 1e-6f;
constexpr size_t MiB = 1ull << 20;
constexpr size_t WS_SMALL = 0, WS_W = 8 * MiB, WS_H = 108 * MiB, WS_RAW = 172 * MiB, WS_CAT = 300 * MiB, WS_BIG = 364 * MiB, WS_END = 684 * MiB;
constexpr size_t SM_MODP = 0;
constexpr size_t SM_AB = 1 * MiB;
constexpr size_t SM_GLOW = 2 * MiB;
constexpr size_t SM_SSQ = 3 * MiB;
constexpr size_t SM_A16 = 5 * MiB;
constexpr size_t SM_GG = 5 * MiB + 65536;
constexpr size_t SM_GLAST = 6 * MiB;
constexpr size_t SM_PROG = 5 * MiB + 131072;
constexpr size_t W_IN0 = 0, W_GLU = 24 * MiB, W_OUT0 = 26 * MiB, W_GU0 = 34 * MiB, W_DN0 = 78 * MiB;
constexpr size_t W_IN1 = 0, W_OUT1 = 24 * MiB, W_GU1 = 32 * MiB, W_DN1 = 76 * MiB;
constexpr size_t B_Y = 0;
constexpr size_t B_S5WT = 128 * MiB, B_S5KT = 132 * MiB, B_S5WU = 144 * MiB, B_S5XC = 176 * MiB;
constexpr size_t B_QE = 192 * MiB, B_OU = 224 * MiB, B_YG = 256 * MiB, B_UG = 288 * MiB;
constexpr size_t B_ATT = 192 * MiB, B_VT = 200 * MiB;
constexpr size_t B_HID = 0;
constexpr int LDS_BYTES = 163840;

struct Params { const float* in[41]; float* out; unsigned char* ws; int ph_lo, ph_hi, mode4, pad; };

__device__ __forceinline__ unsigned f2bf(float f) { unsigned u = __float_as_uint(f); return (u + 0x7fffu + ((u >> 16) & 1u)) >> 16; }
__device__ __forceinline__ float bf2f(unsigned short b) { return __uint_as_float(((unsigned)b) << 16); }
__device__ __forceinline__ unsigned pk2(float lo, float hi) { return f2bf(lo) | (f2bf(hi) << 16); }
__device__ __forceinline__ unsigned cvt_pk_bf16(float lo, float hi) { unsigned r; asm volatile("v_cvt_pk_bf16_f32 %0, %1, %2" : "=v"(r) : "v"(lo), "v"(hi)); return r; }
__device__ __forceinline__ float wave_sum(float v) {
#pragma unroll
    for (int o = 1; o < 64; o <<= 1) v += __shfl_xor(v, o);
    return v;
}
__device__ __forceinline__ float sigmoidf_(float x) { return __builtin_amdgcn_rcpf(1.0f + __expf(-x)); }
__device__ __forceinline__ float siluf_(float x) { return x * __builtin_amdgcn_rcpf(1.0f + __expf(-x)); }
__device__ __forceinline__ f32x4 mfma16(bf16x8 a, bf16x8 b, f32x4 c) { return __builtin_amdgcn_mfma_f32_16x16x32_bf16(a, b, c, 0, 0, 0); }

namespace pg8 {
constexpr int BM = 256, BK = 64, HALF = 128, HTB = HALF * BK * 2, STAGE_BYTES = 8 * HTB, NXCD = 8, WGM = 8;
__host__ __device__ __forceinline__ int lds_byte(int r, int c) { const int st = (r >> 4) * 2 + (c >> 5), rr = r & 15, cc = c & 31, ob = rr * 64 + cc * 2; return st * 1024 + (ob ^ (((ob >> 9) & 1) << 5)); }
__host__ __device__ __forceinline__ void stage_rc(int b, int& R, int& C) { const int st = b / 1024, sb = b % 1024, swz = sb ^ (((sb >> 9) & 1) << 5); R = (st >> 1) * 16 + swz / 64; C = (st & 1) * 32 + (swz % 64) / 2; }
__host__ __device__ __forceinline__ int perm32(int rho) { const int n = rho >> 4, i = rho & 15; return 8 * (i >> 2) + 4 * n + (i & 3); }
struct Unit { int pm, pn; };
struct Gemm { const bf16_t* A; const bf16_t* Bt; int M, N, K; };
struct StaticOrder {
    int nM, nN, nwg, G, c;
    __device__ __forceinline__ void init(int M, int N, int G_, int c_) { nM = M / BM; nN = N / BM; nwg = nM * nN; G = G_; c = c_; }
    __device__ bool next(int i, Unit& u) const {
        const long L = (long)i * G + c; if (L >= nwg) return false;
        int wgid = (int)L; { const int q = nwg / NXCD, r = nwg % NXCD, xcd = wgid % NXCD, off = wgid / NXCD; wgid = (xcd < r ? xcd * (q + 1) : r * (q + 1) + (xcd - r) * q) + off; }
        const int nig = WGM * nN, gid = wgid / nig, fm = gid * WGM, gsz = (nM - fm) < WGM ? (nM - fm) : WGM;
        u.pm = fm + ((wgid % nig) % gsz); u.pn = (wgid % nig) / gsz; return true;
    }
};
struct EpiBf16Store {
    static constexpr bool PERM = true;
    bf16_t* O; int ldc;
    __device__ __forceinline__ void operator()(const f32x4 (&acc)[2][2][4][2], const Unit& u, int wr, int wc, int fr, int fq) const {
        const int row0 = u.pm * BM + wr * 64 + fr, col0 = u.pn * BM + wc * 32 + 8 * fq;
#pragma unroll
        for (int ai = 0; ai < 2; ++ai)
#pragma unroll
            for (int m = 0; m < 4; ++m) { bf16_t* rowp = O + (size_t)(row0 + ai * HALF + m * 16) * ldc + col0;
#pragma unroll
                for (int bj = 0; bj < 2; ++bj) { const f32x4 v0 = acc[ai][bj][m][0], v1 = acc[ai][bj][m][1];
                    u32x4 w; w.x = cvt_pk_bf16(v0[0], v0[1]); w.y = cvt_pk_bf16(v0[2], v0[3]); w.z = cvt_pk_bf16(v1[0], v1[1]); w.w = cvt_pk_bf16(v1[2], v1[3]);
                    *(u32x4*)(rowp + bj * HALF) = w; } }
    }
};
struct EpiIn0 {
    static constexpr bool PERM = true;
    bf16_t* O; int ldc; bf16_t* UG;
    __device__ __forceinline__ void operator()(const f32x4 (&acc)[2][2][4][2], const Unit& u, int wr, int wc, int fr, int fq) const {
        const int row0 = u.pm * BM + wr * 64 + fr, col0 = u.pn * BM + wc * 32 + 8 * fq;
#pragma unroll
        for (int ai = 0; ai < 2; ++ai)
#pragma unroll
            for (int m = 0; m < 4; ++m) { const int r = row0 + ai * HALF + m * 16;
#pragma unroll
                for (int bj = 0; bj < 2; ++bj) { const f32x4 v0 = acc[ai][bj][m][0], v1 = acc[ai][bj][m][1]; const int col = col0 + bj * HALF;
                    u32x4 w; w.x = cvt_pk_bf16(v0[0], v0[1]); w.y = cvt_pk_bf16(v0[2], v0[3]); w.z = cvt_pk_bf16(v1[0], v1[1]); w.w = cvt_pk_bf16(v1[2], v1[3]);
                    bf16_t* dst = (u.pn < 4) ? (UG + ((size_t)(col >> 4) * SEQ + r) * 16 + (col & 15)) : (O + (size_t)r * ldc + col);
                    *(u32x4*)dst = w; } }
    }
};
struct EpiGlu {
    static constexpr bool PERM = true;
    bf16_t* O; int ldc; const bf16_t* Y; int ldy; const float* bias;
    __device__ __forceinline__ void operator()(const f32x4 (&acc)[2][2][4][2], const Unit& u, int wr, int wc, int fr, int fq) const {
        const int row0 = u.pm * BM + wr * 64 + fr, col0 = u.pn * BM + wc * 32 + 8 * fq;
        f32x4 bv[2][2];
#pragma unroll
        for (int bj = 0; bj < 2; ++bj)
#pragma unroll
            for (int n = 0; n < 2; ++n) bv[bj][n] = *(const f32x4*)(bias + col0 + bj * HALF + 4 * n);
#pragma unroll
        for (int ai = 0; ai < 2; ++ai)
#pragma unroll
            for (int m = 0; m < 4; ++m) { const size_t r = (size_t)(row0 + ai * HALF + m * 16);
#pragma unroll
                for (int bj = 0; bj < 2; ++bj) {
                    const u32x4 yv = *(const u32x4*)(Y + r * ldy + col0 + bj * HALF);
                    const f32x4 v0 = acc[ai][bj][m][0] + bv[bj][0], v1 = acc[ai][bj][m][1] + bv[bj][1];
                    float o[8];
                    const unsigned yy[4] = {yv.x, yv.y, yv.z, yv.w};
#pragma unroll
                    for (int j = 0; j < 4; ++j) { const float ylo = __uint_as_float(yy[j] << 16), yhi = __uint_as_float(yy[j] & 0xffff0000u);
                        const float a0 = (j < 2) ? v0[2 * j] : v1[2 * j - 4], a1 = (j < 2) ? v0[2 * j + 1] : v1[2 * j - 3];
                        o[2 * j] = ylo * sigmoidf_(a0); o[2 * j + 1] = yhi * sigmoidf_(a1); }
                    u32x4 w; w.x = cvt_pk_bf16(o[0], o[1]); w.y = cvt_pk_bf16(o[2], o[3]); w.z = cvt_pk_bf16(o[4], o[5]); w.w = cvt_pk_bf16(o[6], o[7]);
                    *(u32x4*)(O + r * ldc + col0 + bj * HALF) = w; } }
    }
};
struct EpiSwiglu {
    static constexpr bool PERM = true;
    bf16_t* O; int ldc;
    __device__ __forceinline__ void operator()(const f32x4 (&acc)[2][2][4][2], const Unit& u, int wr, int wc, int fr, int fq) const {
        const int row0 = u.pm * BM + wr * 64 + fr, col0 = u.pn * HALF + wc * 32 + 8 * fq;
#pragma unroll
        for (int ai = 0; ai < 2; ++ai)
#pragma unroll
            for (int m = 0; m < 4; ++m) { bf16_t* rowp = O + (size_t)(row0 + ai * HALF + m * 16) * ldc + col0;
                float o[8];
#pragma unroll
                for (int n = 0; n < 2; ++n)
#pragma unroll
                    for (int j = 0; j < 4; ++j) { const float g = acc[ai][0][m][n][j], up = acc[ai][1][m][n][j]; o[4 * n + j] = siluf_(g) * up; }
                u32x4 w; w.x = cvt_pk_bf16(o[0], o[1]); w.y = cvt_pk_bf16(o[2], o[3]); w.z = cvt_pk_bf16(o[4], o[5]); w.w = cvt_pk_bf16(o[6], o[7]);
                *(u32x4*)rowp = w; }
    }
};
struct EpiRaw {
    static constexpr bool PERM = true;
    bf16_t* C; int ldc; float* ssq;
    __device__ __forceinline__ void operator()(const f32x4 (&acc)[2][2][4][2], const Unit& u, int wr, int wc, int fr, int fq) const {
        const int row0 = u.pm * BM + wr * 64 + fr, col0 = u.pn * BM + wc * 32 + 8 * fq;
#pragma unroll
        for (int ai = 0; ai < 2; ++ai)
#pragma unroll
            for (int m = 0; m < 4; ++m) { const int r = row0 + ai * HALF + m * 16; bf16_t* rowp = C + (size_t)r * ldc + col0; float s = 0.f;
#pragma unroll
                for (int bj = 0; bj < 2; ++bj) { const f32x4 v0 = acc[ai][bj][m][0], v1 = acc[ai][bj][m][1];
                    s += (v0[0] * v0[0] + v0[1] * v0[1]) + (v0[2] * v0[2] + v0[3] * v0[3]) + (v1[0] * v1[0] + v1[1] * v1[1]) + (v1[2] * v1[2] + v1[3] * v1[3]);
                    u32x4 w; w.x = cvt_pk_bf16(v0[0], v0[1]); w.y = cvt_pk_bf16(v0[2], v0[3]); w.z = cvt_pk_bf16(v1[0], v1[1]); w.w = cvt_pk_bf16(v1[2], v1[3]);
                    *(u32x4*)(rowp + bj * HALF) = w; }
                s += __shfl_xor(s, 16); s += __shfl_xor(s, 32);
                if (fq == 0) ssq[(size_t)r * 32 + u.pn * 4 + wc] = s; }
    }
};

template <class Epi>
__device__ __forceinline__ void gemm_phase(LAS unsigned char* lds, const Gemm g, const StaticOrder& S, const Epi& E) {
    const int tid = threadIdx.x, wid = __builtin_amdgcn_readfirstlane(tid >> 6), lane = tid & 63, wr = wid >> 2, wc = wid & 3, fr = lane & 15, fq = lane >> 4;
    const int K = g.K, nt = K / BK;
    unsigned voffA[2], voffB[2];
#pragma unroll
    for (int i = 0; i < 2; ++i) { int R, C; stage_rc(tid * 16 + i * 8192, R, C); const int Rb = Epi::PERM ? ((R & ~31) + perm32(R & 31)) : R;
        voffA[i] = (unsigned)(R * K + C) * 2u; voffB[i] = (unsigned)(Rb * K + C) * 2u; }
    const size_t kstep = (size_t)(BK * 2);
    const size_t hstep = (size_t)HALF * K * 2;
    const size_t tstep = 2 * hstep;
    const unsigned ldsw = (unsigned)wid * 1024u;
    const int aoff = lds_byte(wr * 64 + fr, fq * 8), boff = lds_byte(wc * 32 + fr, fq * 8);
#define PG8_SA(b, h) (((b) * 2 + (h)) * HTB)
#define PG8_SB(b, h) ((4 + (b) * 2 + (h)) * HTB)
#define PG8_STAGE(bufoff, gbase, voff) do { _Pragma("unroll") for (int _i = 0; _i < 2; ++_i) \
        __builtin_amdgcn_global_load_lds((const unsigned*)((const char*)(gbase) + (voff)[_i]), (LAS unsigned*)(lds + (bufoff) + ldsw + _i * 8192), 16, 0, 0); } while (0)
#define PG8_LDA(dst, b, h) do { _Pragma("unroll") for (int m = 0; m < 4; ++m) _Pragma("unroll") for (int k = 0; k < 2; ++k) dst[m][k] = *(const LAS bf16x8*)(lds + PG8_SA(b, h) + aoff + m * 2048 + k * 1024); } while (0)
#define PG8_LDB(dst, b, h) do { _Pragma("unroll") for (int n = 0; n < 2; ++n) _Pragma("unroll") for (int k = 0; k < 2; ++k) dst[n][k] = *(const LAS bf16x8*)(lds + PG8_SB(b, h) + boff + n * 2048 + k * 1024); } while (0)
#define PG8_MMA(ai, bj, At, Bt) do { __builtin_amdgcn_s_setprio(1); _Pragma("unroll") for (int m = 0; m < 4; ++m) _Pragma("unroll") for (int n = 0; n < 2; ++n) _Pragma("unroll") for (int k = 0; k < 2; ++k) \
        acc[ai][bj][m][n] = __builtin_amdgcn_mfma_f32_16x16x32_bf16(Bt[n][k], At[m][k], acc[ai][bj][m][n], 0, 0, 0); __builtin_amdgcn_s_setprio(0); } while (0)
#define PG8_WAIT_V(n) asm volatile("s_waitcnt vmcnt(" #n ")" ::: "memory")
#define PG8_WAIT_L(n) asm volatile("s_waitcnt lgkmcnt(" #n ")" ::: "memory")
#define PG8_BAR __builtin_amdgcn_s_barrier()
#define PG8_SCHED __builtin_amdgcn_sched_barrier(0)
    Unit cur, nxt; int ui = 0;
    if (!S.next(0, cur)) return;
    f32x4 acc[2][2][4][2];
#pragma unroll
    for (int a = 0; a < 2; ++a)
#pragma unroll
        for (int b = 0; b < 2; ++b)
#pragma unroll
            for (int m = 0; m < 4; ++m)
#pragma unroll
                for (int n = 0; n < 2; ++n) acc[a][b][m][n] = (f32x4){0.f, 0.f, 0.f, 0.f};
    bf16x8 At[4][2], B0[2][2], B1[2][2];
    const char* cA = (const char*)g.A + (size_t)cur.pm * tstep; const char* cB = (const char*)g.Bt + (size_t)cur.pn * tstep;
    PG8_STAGE(PG8_SB(0, 0), cB, voffB); PG8_STAGE(PG8_SB(0, 1), cB + hstep, voffB); PG8_STAGE(PG8_SA(0, 0), cA, voffA); PG8_STAGE(PG8_SA(0, 1), cA + hstep, voffA);
    if (wr == 1) PG8_BAR;
    PG8_WAIT_V(2); PG8_BAR;
    PG8_STAGE(PG8_SB(1, 0), cB + kstep, voffB); PG8_STAGE(PG8_SA(1, 0), cA + kstep, voffA); PG8_STAGE(PG8_SB(1, 1), cB + hstep + kstep, voffB);
    PG8_WAIT_V(6); PG8_BAR;
    for (;;) {
        const bool has_next = S.next(ui + 1, nxt);
        const char* nA = has_next ? (const char*)g.A + (size_t)nxt.pm * tstep : cA; const char* nB = has_next ? (const char*)g.Bt + (size_t)nxt.pn * tstep : cB;
        for (int t = 0; t < nt; t += 2) {
            const bool last = (t == nt - 2);
            const char* a1 = cA + (size_t)(t + 1) * kstep;
            const char* a2 = last ? nA : cA + (size_t)(t + 2) * kstep; const char* b2 = last ? nB : cB + (size_t)(t + 2) * kstep;
            const char* a3 = a2 + kstep; const char* b3 = b2 + kstep;
            PG8_LDB(B0, 0, 0); PG8_LDB(B1, 0, 1); PG8_SCHED; PG8_LDA(At, 0, 0); PG8_STAGE(PG8_SA(1, 1), a1 + hstep, voffA);
            PG8_WAIT_V(8); PG8_WAIT_L(0); PG8_BAR; PG8_MMA(0, 0, At, B0); PG8_MMA(0, 1, At, B1); PG8_BAR; PG8_SCHED;
            PG8_LDA(At, 0, 1); PG8_STAGE(PG8_SB(0, 0), b2, voffB); PG8_STAGE(PG8_SB(0, 1), b2 + hstep, voffB); PG8_STAGE(PG8_SA(0, 0), a2, voffA);
            PG8_WAIT_V(8); PG8_WAIT_L(0); PG8_BAR; PG8_MMA(1, 0, At, B0); PG8_MMA(1, 1, At, B1); PG8_BAR; PG8_SCHED;
            PG8_LDB(B0, 1, 0); PG8_LDB(B1, 1, 1); PG8_SCHED; PG8_LDA(At, 1, 0); PG8_STAGE(PG8_SA(0, 1), a2 + hstep, voffA);
            PG8_WAIT_V(8); PG8_WAIT_L(0); PG8_BAR; PG8_MMA(0, 0, At, B0); PG8_MMA(0, 1, At, B1); PG8_BAR; PG8_SCHED;
            PG8_LDA(At, 1, 1); PG8_STAGE(PG8_SB(1, 0), b3, voffB); PG8_STAGE(PG8_SB(1, 1), b3 + hstep, voffB); PG8_STAGE(PG8_SA(1, 0), a3, voffA);
            PG8_WAIT_V(8); PG8_WAIT_L(0); PG8_BAR; PG8_MMA(1, 0, At, B0); PG8_MMA(1, 1, At, B1); PG8_BAR; PG8_SCHED;
        }
        if (wr == 0) PG8_BAR;
        E(acc, cur, wr, wc, fr, fq);
        if (!has_next) break;
#pragma unroll
        for (int a = 0; a < 2; ++a)
#pragma unroll
            for (int b = 0; b < 2; ++b)
#pragma unroll
                for (int m = 0; m < 4; ++m)
#pragma unroll
                    for (int n = 0; n < 2; ++n) acc[a][b][m][n] = (f32x4){0.f, 0.f, 0.f, 0.f};
        cur = nxt; cA = nA; cB = nB; ++ui;
        if (wr == 1) PG8_BAR;
    }
    PG8_WAIT_V(0);
    PG8_BAR;
#undef PG8_SA
#undef PG8_SB
#undef PG8_STAGE
#undef PG8_LDA
#undef PG8_LDB
#undef PG8_MMA
#undef PG8_WAIT_V
#undef PG8_WAIT_L
#undef PG8_BAR
#undef PG8_SCHED
}
}

struct Ctx {
    LAS unsigned char* lds;
    int tid, lane, wave, G, bid;
    const Params* p;
};
#define WSP(T, off) ((T*)(P.ws + (off)))

template <bool SWAP>
__device__ __forceinline__ f32x4 tile_mm(const LAS bf16_t* A, int lda, const LAS bf16_t* B, int ldb, int m0, int n0, int ksteps, int fr, int fq) {
    f32x4 acc = (f32x4){0.f, 0.f, 0.f, 0.f};
    for (int ks = 0; ks < ksteps; ++ks) {
        const bf16x8 a = *(const LAS bf16x8*)(A + (m0 + fr) * lda + ks * 32 + fq * 8);
        const bf16x8 b = *(const LAS bf16x8*)(B + (n0 + fr) * ldb + ks * 32 + fq * 8);
        acc = SWAP ? mfma16(b, a, acc) : mfma16(a, b, acc);
    }
    return acc;
}

__device__ __forceinline__ void transpose_item(const float* W, int K, int Nsrc, int c0, bf16_t* WT, int mode, LAS float* scr, int kb, int nb, int lane) {
    const int k0 = 64 * kb, n0 = 32 * nb;
#pragma unroll 8
    for (int i = 0; i < 32; ++i) { const int kk = 2 * i + (lane >> 5); scr[kk * 33 + (lane & 31)] = W[(size_t)(k0 + kk) * Nsrc + c0 + n0 + (lane & 31)]; }
    asm volatile("s_waitcnt lgkmcnt(0)" ::: "memory");
    const int c = lane & 7;
#pragma unroll
    for (int j = 0; j < 4; ++j) { const int n = (lane >> 3) + 8 * j; const LAS float* s = scr + (8 * c) * 33 + n;
        u32x4 o; o.x = pk2(s[0 * 33], s[1 * 33]); o.y = pk2(s[2 * 33], s[3 * 33]); o.z = pk2(s[4 * 33], s[5 * 33]); o.w = pk2(s[6 * 33], s[7 * 33]);
        const int nn = n0 + n; const int row = (mode == 0) ? nn : ((nn >> 7) * 256 + (nn & 127) + (mode == 2 ? 128 : 0));
        *(u32x4*)(WT + (size_t)row * K + k0 + 8 * c) = o; }
    asm volatile("s_waitcnt lgkmcnt(0)" ::: "memory");
}
__device__ __forceinline__ void tr_job(const Ctx& F, int& base, const float* W, int K, int Nsrc, int c0, int ncols, int mode, bf16_t* WT, LAS float* scr, int gw = -1, int NGW = 0) {
    if (gw < 0) { gw = F.bid * 8 + F.wave; NGW = F.G * 8; }
    const int nnb = ncols / 32, items = (K / 64) * nnb;
    const int first = (gw - base % NGW + NGW) % NGW;
    for (int it = first; it < items; it += NGW) transpose_item(W, K, Nsrc, c0, WT, mode, scr, it / nnb, it % nnb, F.lane);
    base += items;
}

__device__ __forceinline__ void s5_precompute(const Ctx& F, int g) {
    const Params& P = *F.p;
    LAS float* AP = (LAS float*)F.lds;
    LAS float* BB = AP + 17 * 128;
    LAS float* CC = BB + 2048;
    LAS float* KD = CC + 2048;
    LAS float* FF = KD + 4096;
    const int tid = F.tid;
    if (tid < 64) {
        const int n = tid; const float lr = P.in[9][g * 64 + n], li = P.in[10][g * 64 + n], dt = expf(P.in[11][g]);
        const float mag = expf(lr * dt); float sn, cs; sincosf(li * dt, &sn, &cs);
        const float ar = mag * cs, ai = mag * sn, den = lr * lr + li * li, nr = ar - 1.0f, ni = ai;
        FF[2 * n] = (nr * lr + ni * li) / den; FF[2 * n + 1] = (ni * lr - nr * li) / den;
        float pr = 1.f, pi = 0.f;
        for (int d = 0; d <= 16; ++d) { AP[(d * 64 + n) * 2] = pr; AP[(d * 64 + n) * 2 + 1] = pi; const float tr = pr * ar - pi * ai, ti = pr * ai + pi * ar; pr = tr; pi = ti; }
        float* A16 = WSP(float, WS_SMALL + SM_A16) + g * 128;
        A16[n] = AP[(16 * 64 + n) * 2]; A16[64 + n] = AP[(16 * 64 + n) * 2 + 1];
    }
    __syncthreads();
    for (int idx = tid; idx < 1024; idx += 512) {
        const int n = idx >> 4, q = idx & 15; const float br = P.in[12][(g * 64 + n) * 16 + q], bi = P.in[13][(g * 64 + n) * 16 + q], fr_ = FF[2 * n], fi_ = FF[2 * n + 1];
        BB[idx * 2] = fr_ * br - fi_ * bi; BB[idx * 2 + 1] = fr_ * bi + fi_ * br;
        const int p = idx >> 6, nn = idx & 63;
        CC[idx * 2] = P.in[14][(g * 16 + p) * 64 + nn]; CC[idx * 2 + 1] = P.in[15][(g * 16 + p) * 64 + nn];
    }
    __syncthreads();
    for (int idx = tid; idx < 4096; idx += 512) {
        const int d = idx >> 8, p = (idx >> 4) & 15, q = idx & 15; float s = 0.f;
        for (int n = 0; n < 64; ++n) { const float cr = CC[(p * 64 + n) * 2], ci = CC[(p * 64 + n) * 2 + 1], ar = AP[(d * 64 + n) * 2], ai = AP[(d * 64 + n) * 2 + 1], br = BB[(n * 16 + q) * 2], bi = BB[(n * 16 + q) * 2 + 1];
            const float zr = cr * ar - ci * ai, zi = cr * ai + ci * ar; s += zr * br - zi * bi; }
        if (d == 0 && p == q) s += P.in[16][g * 16 + p];
        KD[idx] = s;
    }
    __syncthreads();
    bf16_t* KT = WSP(bf16_t, WS_BIG + B_S5KT) + (size_t)g * 256 * 384;
    for (int ch = tid; ch < 256 * 48; ch += 512) {
        const int n = ch / 48, k0 = (ch % 48) * 8, t = n >> 4, p = n & 15; float v[8];
#pragma unroll
        for (int j = 0; j < 8; ++j) { const int k = k0 + j;
            if (k < 256) { const int s = k >> 4, q = k & 15; v[j] = (s <= t) ? KD[((t - s) * 16 + p) * 16 + q] : 0.f; }
            else { const int kk = k - 256, nn = kk & 63; const float cr = CC[(p * 64 + nn) * 2], ci = CC[(p * 64 + nn) * 2 + 1], ar = AP[((t + 1) * 64 + nn) * 2], ai = AP[((t + 1) * 64 + nn) * 2 + 1];
                v[j] = (kk < 64) ? (cr * ar - ci * ai) : -(cr * ai + ci * ar); } }
        u32x4 o; o.x = pk2(v[0], v[1]); o.y = pk2(v[2], v[3]); o.z = pk2(v[4], v[5]); o.w = pk2(v[6], v[7]);
        *(u32x4*)(KT + (size_t)n * 384 + k0) = o;
    }
    bf16_t* WT = WSP(bf16_t, WS_BIG + B_S5WT) + (size_t)g * 128 * 256;
    for (int ch = tid; ch < 128 * 32; ch += 512) {
        const int np = ch / 32, k0 = (ch % 32) * 8, n = np & 63; float v[8];
#pragma unroll
        for (int j = 0; j < 8; ++j) { const int k = k0 + j, s = k >> 4, q = k & 15; const float ar = AP[((15 - s) * 64 + n) * 2], ai = AP[((15 - s) * 64 + n) * 2 + 1], br = BB[(n * 16 + q) * 2], bi = BB[(n * 16 + q) * 2 + 1];
            v[j] = (np < 64) ? (ar * br - ai * bi) : (ar * bi + ai * br); }
        u32x4 o; o.x = pk2(v[0], v[1]); o.y = pk2(v[2], v[3]); o.z = pk2(v[4], v[5]); o.w = pk2(v[6], v[7]);
        *(u32x4*)(WT + (size_t)np * 256 + k0) = o;
    }
    __syncthreads();
}

__device__ __forceinline__ void ada_gemv(const Ctx& F, const LAS float* sc, int layer, int gw, int NGW) {
    const Params& P = *F.p; float* MODP = WSP(float, WS_SMALL + SM_MODP);
    for (int task = gw; task < 192 * 8; task += NGW) {
        const int kp = task & 7, cb = task >> 3;
        const float* W = P.in[layer ? 27 : 2] + (size_t)(kp * 256) * 12288 + cb * 64 + F.lane;
        float acc = 0.f;
#pragma unroll 16
        for (int k = 0; k < 256; ++k) acc += sc[kp * 256 + k] * W[(size_t)k * 12288];
        MODP[(size_t)(kp * 2 + layer) * 12288 + cb * 64 + F.lane] = acc;
    }
}
__device__ __forceinline__ void ada_gemv_layer1_idle(const Ctx& F, int first_idle, int end_idle) {
    const Params& P = *F.p;
    LAS float* sc = (LAS float*)F.lds;
    for (int k = F.tid; k < DM; k += 512) sc[k] = siluf_(P.in[1][k]);
    __syncthreads();
    ada_gemv(F, sc, 1, (F.bid - first_idle) * 8 + F.wave, (end_idle - first_idle) * 8);
    __syncthreads();
    LAS float* scr = (LAS float*)F.lds + F.wave * (64 * 33);
    char* Wb = (char*)WSP(bf16_t, WS_W); int base = 0; const int gw = (F.bid - first_idle) * 8 + F.wave, NGW = (end_idle - first_idle) * 8;
    tr_job(F, base, P.in[23], 2048, 2048, 0, 2048, 0, (bf16_t*)(Wb + W_OUT0), scr, gw, NGW);
    tr_job(F, base, P.in[26], 5632, 2048, 0, 2048, 0, (bf16_t*)(Wb + W_DN0), scr, gw, NGW);
    tr_job(F, base, P.in[33], 2048, 6160, 0, 6144, 0, (bf16_t*)(Wb + W_IN1), scr, gw, NGW);
}
__device__ __forceinline__ void phase_prologue(const Ctx& F) {
    const Params& P = *F.p;
    if (F.bid < 64) s5_precompute(F, F.bid);
    LAS float* sc = (LAS float*)F.lds;
    for (int k = F.tid; k < DM; k += 512) sc[k] = siluf_(P.in[1][k]);
    __syncthreads();
    if (F.bid >= 64) ada_gemv(F, sc, 0, (F.bid - 64) * 8 + F.wave, (F.G - 64) * 8);
    __syncthreads();
    LAS float* scr = (LAS float*)F.lds + F.wave * (64 * 33);
    char* Wb = (char*)WSP(bf16_t, WS_W); int base = 0;
    tr_job(F, base, P.in[8], 2048, 4112, 0, 4096, 0, (bf16_t*)(Wb + W_IN0), scr);
    tr_job(F, base, P.in[17], 1024, 1024, 0, 1024, 0, (bf16_t*)(Wb + W_GLU), scr);
    tr_job(F, base, P.in[24], 2048, 5632, 0, 5632, 1, (bf16_t*)(Wb + W_GU0), scr);
    tr_job(F, base, P.in[25], 2048, 5632, 0, 5632, 2, (bf16_t*)(Wb + W_GU0), scr);
}
__device__ __forceinline__ void convert_layer1_in(const Ctx& F) {
    const Params& P = *F.p;
    LAS float* scr = (LAS float*)F.lds + F.wave * (64 * 33);
    char* Wb = (char*)WSP(bf16_t, WS_W); int base = 0;
    tr_job(F, base, P.in[33], 2048, 6160, 0, 6144, 0, (bf16_t*)(Wb + W_IN1), scr);
}
__device__ __forceinline__ void convert_layer1_rest_idle(const Ctx& F, int first_idle, int end_idle) {
    const Params& P = *F.p;
    LAS float* scr = (LAS float*)F.lds + F.wave * (64 * 33);
    char* Wb = (char*)WSP(bf16_t, WS_W); int base = 0; const int gw = (F.bid - first_idle) * 8 + F.wave, NGW = (end_idle - first_idle) * 8;
    tr_job(F, base, P.in[37], 2048, 2048, 0, 2048, 0, (bf16_t*)(Wb + W_OUT1), scr, gw, NGW);
    tr_job(F, base, P.in[38], 2048, 5632, 0, 5632, 1, (bf16_t*)(Wb + W_GU1), scr, gw, NGW);
    tr_job(F, base, P.in[39], 2048, 5632, 0, 5632, 2, (bf16_t*)(Wb + W_GU1), scr, gw, NGW);
    tr_job(F, base, P.in[40], 5632, 2048, 0, 2048, 0, (bf16_t*)(Wb + W_DN1), scr, gw, NGW);
}

__device__ __forceinline__ float treduce16(float (&t)[16], int lane) {
#pragma unroll
    for (int half = 8, off = 32; half >= 1; half >>= 1, off >>= 1) {
        const bool up = (lane & off) != 0;
#pragma unroll
        for (int i = 0; i < half; ++i) { const float a = t[i], b = t[i + half]; const float send = up ? a : b, keep = up ? b : a; t[i] = keep + __shfl_xor(send, off); }
    }
    float r = t[0]; r += __shfl_xor(r, 2); r += __shfl_xor(r, 1); return r;
}
struct RowCfg;
template <bool POST, bool PRE>
__device__ __forceinline__ void row_core(const Params& P, const RowCfg& c, LAS float* vA, LAS float* vB, LAS float* vP, const bf16_t* RAW, const float* SSQ, bf16_t* H, int row, int lane, f32x4 (&v)[8]);
struct RowCfg { int lpost, gt_off, wpost_in, lpre, wpre_in, sc_off, sh_off, thin_in, thin_nsrc, thin_c0; const float* xsrc; float* thin_out; };
template <bool POST, bool PRE>
__device__ __forceinline__ void row_core(const Params& P, const RowCfg& c, LAS float* vA, LAS float* vB, LAS float* vP, const bf16_t* RAW, const float* SSQ, bf16_t* H, int row, int lane, f32x4 (&v)[8]) {
    const f32x4* xs = (const f32x4*)(c.xsrc + (size_t)row * DM) + lane;
#pragma unroll
    for (int j = 0; j < 8; ++j) v[j] = xs[64 * j];
    if (POST) {
        const u32x2* rs = (const u32x2*)(RAW + (size_t)row * DM) + lane;
        float s = (lane < 32) ? SSQ[(size_t)row * 32 + lane] : 0.f; s = wave_sum(s);
        const float rstd = rsqrtf(s * (1.0f / DM) + EPS);
        f32x4* os = (f32x4*)(P.out + (size_t)row * DM) + lane;
#pragma unroll
        for (int j = 0; j < 8; ++j) { const u32x2 rb = rs[64 * j]; const f32x4 r = (f32x4){__uint_as_float(rb.x << 16), __uint_as_float(rb.x & 0xffff0000u), __uint_as_float(rb.y << 16), __uint_as_float(rb.y & 0xffff0000u)};
            const f32x4 pv = *(const LAS f32x4*)(vP + j * 256 + lane * 4); v[j] += r * rstd * pv; os[64 * j] = v[j]; }
    }
    if (PRE) {
        float s2 = 0.f;
#pragma unroll
        for (int j = 0; j < 8; ++j) s2 += (v[j][0] * v[j][0] + v[j][1] * v[j][1]) + (v[j][2] * v[j][2] + v[j][3] * v[j][3]);
        s2 = wave_sum(s2);
        const float rstd2 = rsqrtf(s2 * (1.0f / DM) + EPS);
        u32x2* hs = (u32x2*)(H + (size_t)row * DM) + lane;
#pragma unroll
        for (int j = 0; j < 8; ++j) { const f32x4 a = *(const LAS f32x4*)(vA + j * 256 + lane * 4), b = *(const LAS f32x4*)(vB + j * 256 + lane * 4);
            v[j] = v[j] * rstd2 * a + b; u32x2 w; w.x = cvt_pk_bf16(v[j][0], v[j][1]); w.y = cvt_pk_bf16(v[j][2], v[j][3]); hs[64 * j] = w; }
    }
}
template <bool POST, bool PRE, bool THIN>
__device__ __forceinline__ void row_phase(const Ctx& F, const RowCfg c) {
    const Params& P = *F.p;
    LAS float* vA = (LAS float*)F.lds; LAS float* vB = vA + 2048; LAS float* vP = vB + 2048; LAS float* tw = vP + 2048;
    const float* MODP = WSP(float, WS_SMALL + SM_MODP);
    const float* adab_post = P.in[c.lpost ? 28 : 3]; const float* adab_pre = P.in[c.lpre ? 28 : 3];
    for (int j = F.tid; j < DM; j += 512) {
        if (POST) { float g = adab_post[c.gt_off + j]; for (int pp = 0; pp < 8; ++pp) g += MODP[(size_t)(pp * 2 + c.lpost) * 12288 + c.gt_off + j]; vP[j] = g * P.in[c.wpost_in][j]; }
        if (PRE) { float s = adab_pre[c.sc_off + j], h = adab_pre[c.sh_off + j];
            for (int pp = 0; pp < 8; ++pp) { s += MODP[(size_t)(pp * 2 + c.lpre) * 12288 + c.sc_off + j]; h += MODP[(size_t)(pp * 2 + c.lpre) * 12288 + c.sh_off + j]; }
            vA[j] = P.in[c.wpre_in][j] * (1.0f + s); vB[j] = h; }
    }
    if (THIN) { const float* W = P.in[c.thin_in]; for (int e = F.tid; e < 16 * 2048; e += 512) { const int k = e >> 4, cc = e & 15; tw[cc * 2048 + k] = W[(size_t)k * c.thin_nsrc + c.thin_c0 + cc]; } }
    __syncthreads();
    const int gw = F.bid * 8 + F.wave, NGW = F.G * 8, lane = F.lane;
    const bf16_t* RAW = WSP(bf16_t, WS_RAW); const float* SSQ = WSP(float, WS_SMALL + SM_SSQ); bf16_t* H = WSP(bf16_t, WS_H);
    if (!THIN) {
        for (int row = gw; row < SEQ; row += NGW) { f32x4 v[8]; row_core<POST, PRE>(P, c, vA, vB, vP, RAW, SSQ, H, row, lane, v); }
    } else {
        for (int row = gw; row < SEQ; row += 2 * NGW) {
            f32x4 v0[8], v1[8];
            const int rowB = row + NGW; const bool hasB = rowB < SEQ;
            row_core<POST, PRE>(P, c, vA, vB, vP, RAW, SSQ, H, row, lane, v0);
            if (hasB) row_core<POST, PRE>(P, c, vA, vB, vP, RAW, SSQ, H, rowB, lane, v1);
            else {
#pragma unroll
                for (int j = 0; j < 8; ++j) v1[j] = (f32x4){0.f, 0.f, 0.f, 0.f}; }
            float t0[16], t1[16];
#pragma unroll
            for (int cc = 0; cc < 16; ++cc) { float a0 = 0.f, a1 = 0.f;
#pragma unroll
                for (int j = 0; j < 8; ++j) { const f32x4 w = *(const LAS f32x4*)(tw + cc * 2048 + j * 256 + lane * 4);
                    a0 += (v0[j][0] * w[0] + v0[j][1] * w[1]) + (v0[j][2] * w[2] + v0[j][3] * w[3]);
                    a1 += (v1[j][0] * w[0] + v1[j][1] * w[1]) + (v1[j][2] * w[2] + v1[j][3] * w[3]); }
                t0[cc] = a0; t1[cc] = a1; }
            const float r0 = treduce16(t0, lane), r1 = treduce16(t1, lane);
            if ((lane & 3) == 0) { c.thin_out[(size_t)row * 16 + ((lane >> 2) & 15)] = r0; if (hasB) c.thin_out[(size_t)rowB * 16 + ((lane >> 2) & 15)] = r1; }
        }
    }
}

__device__ __forceinline__ void s5_wu_phase(const Ctx& F) {
    const Params& P = *F.p;
    const bf16_t* UG = WSP(bf16_t, WS_BIG + B_UG); const bf16_t* WTb = WSP(bf16_t, WS_BIG + B_S5WT); float* WU = WSP(float, WS_BIG + B_S5WU);
    const int gw = F.bid * 8 + F.wave, NGW = F.G * 8, lane = F.lane, fr = lane & 15, fq = lane >> 4;
    for (int task = gw; task < 64 * 64; task += NGW) {
        const int g = task >> 6, c0 = (task & 63) * 16;
        bf16x8 a[8];
#pragma unroll
        for (int ks = 0; ks < 8; ++ks) a[ks] = *(const bf16x8*)(UG + ((size_t)g * SEQ + (size_t)(c0 + fr) * 16) * 16 + ks * 32 + fq * 8);
        const bf16_t* WT = WTb + (size_t)g * 128 * 256;
#pragma unroll 2
        for (int nt = 0; nt < 8; ++nt) {
            f32x4 acc = (f32x4){0.f, 0.f, 0.f, 0.f};
#pragma unroll
            for (int ks = 0; ks < 8; ++ks) { const bf16x8 b = *(const bf16x8*)(WT + (size_t)(nt * 16 + fr) * 256 + ks * 32 + fq * 8); acc = mfma16(b, a[ks], acc); }
            *(f32x4*)(WU + ((size_t)g * 1024 + c0 + fr) * 128 + nt * 16 + fq * 4) = acc;
        }
    }
}
__device__ __forceinline__ float gelu_tanh(float x) { const float z = 0.7978845608028654f * (x + 0.044715f * x * x * x); const float e = __expf(2.0f * z); const float th = 1.0f - 2.0f * __builtin_amdgcn_rcpf(e + 1.0f); return 0.5f * x * (1.0f + th); }
__device__ __forceinline__ void s5_group_phase(const Ctx& F, int g) {
    const Params& P = *F.p;
    const bf16_t* UG = WSP(bf16_t, WS_BIG + B_UG) + (size_t)g * SEQ * 16; const float* WU = WSP(float, WS_BIG + B_S5WU) + (size_t)g * 1024 * 128;
    bf16_t* XC = WSP(bf16_t, WS_BIG + B_S5XC) + (size_t)g * 1024 * 128; const bf16_t* KT = WSP(bf16_t, WS_BIG + B_S5KT) + (size_t)g * 256 * 384;
    bf16_t* YG = WSP(bf16_t, WS_BIG + B_YG);
    const int tid = F.tid, lane = F.lane, fr = lane & 15, fq = lane >> 4;
    {
        LAS float* wu = (LAS float*)F.lds;
        LAS bf16_t* xs = (LAS bf16_t*)(F.lds + 65536);
        const float* A16 = WSP(float, WS_SMALL + SM_A16) + g * 128; const float ar = A16[lane], ai = A16[64 + lane]; float cr = 0.f, ci = 0.f;
        for (int blk = 0; blk < 8; ++blk) {
            f32x4 t[8];
#pragma unroll
            for (int i = 0; i < 8; ++i) t[i] = *(const f32x4*)(WU + (size_t)blk * 16384 + (size_t)(i * 512 + tid) * 4);
#pragma unroll
            for (int i = 0; i < 8; ++i) *(LAS f32x4*)(wu + (i * 512 + tid) * 4) = t[i];
            __syncthreads();
            if (F.wave == 0) {
#pragma unroll 8
                for (int c = 0; c < 128; ++c) { const float wr_ = wu[c * 128 + lane], wi_ = wu[c * 128 + 64 + lane];
                    xs[c * 128 + lane] = (bf16_t)f2bf(cr); xs[c * 128 + 64 + lane] = (bf16_t)f2bf(ci);
                    const float nr = ar * cr - ai * ci + wr_, ni = ar * ci + ai * cr + wi_; cr = nr; ci = ni; }
            }
            __syncthreads();
#pragma unroll
            for (int i = 0; i < 4; ++i) *(u32x4*)(XC + (size_t)blk * 16384 + (size_t)(i * 512 + tid) * 8) = *(const LAS u32x4*)(xs + (i * 512 + tid) * 8);
        }
    }
    __threadfence(); __syncthreads();
    LAS bf16_t* As = (LAS bf16_t*)F.lds;
    bf16x8 bfr[2][12];
#pragma unroll
    for (int t2 = 0; t2 < 2; ++t2)
#pragma unroll
        for (int ks = 0; ks < 12; ++ks) bfr[t2][ks] = *(const bf16x8*)(KT + (size_t)((F.wave * 2 + t2) * 16 + fr) * 384 + ks * 32 + fq * 8);
    u32x4 pu, px; px = (u32x4){0u, 0u, 0u, 0u};
    pu = *(const u32x4*)(UG + (size_t)tid * 8); if (tid < 256) px = *(const u32x4*)(XC + (size_t)tid * 8);
    *(LAS u32x4*)(As + (tid >> 5) * 392 + (tid & 31) * 8) = pu; if (tid < 256) *(LAS u32x4*)(As + (tid >> 4) * 392 + 256 + (tid & 15) * 8) = px;
    __syncthreads();
    for (int mt = 0; mt < 64; ++mt) {
        const int c0 = mt * 16, buf = mt & 1;
        if (mt + 1 < 64) { pu = *(const u32x4*)(UG + (size_t)(c0 + 16) * 256 + (size_t)tid * 8); if (tid < 256) px = *(const u32x4*)(XC + (size_t)(c0 + 16) * 128 + (size_t)tid * 8); }
        bf16x8 a[12];
#pragma unroll
        for (int ks = 0; ks < 12; ++ks) a[ks] = *(const LAS bf16x8*)(As + buf * 6272 + fr * 392 + ks * 32 + fq * 8);
#pragma unroll
        for (int t2 = 0; t2 < 2; ++t2) {
            f32x4 acc = (f32x4){0.f, 0.f, 0.f, 0.f};
#pragma unroll
            for (int ks = 0; ks < 12; ++ks) acc = mfma16(bfr[t2][ks], a[ks], acc);
            const int t = F.wave * 2 + t2;
            u32x2 w; w.x = pk2(gelu_tanh(acc[0]), gelu_tanh(acc[1])); w.y = pk2(gelu_tanh(acc[2]), gelu_tanh(acc[3]));
            *(u32x2*)(YG + (size_t)((c0 + fr) * 16 + t) * 1024 + g * 16 + fq * 4) = w;
        }
        if (mt + 1 < 64) { *(LAS u32x4*)(As + (buf ^ 1) * 6272 + (tid >> 5) * 392 + (tid & 31) * 8) = pu; if (tid < 256) *(LAS u32x4*)(As + (buf ^ 1) * 6272 + (tid >> 4) * 392 + 256 + (tid & 15) * 8) = px; }
        __syncthreads();
    }
}

__device__ __forceinline__ void gdn_local_unit(const Ctx& F, int hv, int n) {
    const Params& P = *F.p;
    LAS unsigned char* lds = F.lds;
    LAS float* tmp = (LAS float*)lds;
    LAS float* Lf = (LAS float*)lds;
    LAS bf16_t* Tb = (LAS bf16_t*)(lds + 16384);
    LAS bf16_t* At = (LAS bf16_t*)(lds + 25600);
    LAS bf16_t* wT = (LAS bf16_t*)(lds + 34816);
    LAS bf16_t* uT = (LAS bf16_t*)(lds + 53248);
    LAS bf16_t* qn = (LAS bf16_t*)(lds + 71680);
    LAS bf16_t* kn = (LAS bf16_t*)(lds + 89088);
    LAS bf16_t* vbT = (LAS bf16_t*)(lds + 106496);
    LAS bf16_t* kbgT = (LAS bf16_t*)(lds + 124928);
    LAS bf16_t* kdT = (LAS bf16_t*)(lds + 143360);
    LAS float* gcs = (LAS float*)(lds + 161792);
    LAS float* bts = gcs + 64;
    const int tid = F.tid, lane = F.lane, w = F.wave, fr = lane & 15, fq = lane >> 4;
    const int hq = hv >> 1, t0 = n * 64, u = hv * 256 + n;
    const bf16_t* Y0 = WSP(bf16_t, WS_BIG + B_Y); const float* AB = WSP(float, WS_SMALL + SM_AB);
    if (tid < 64) {
        const float av = AB[(size_t)(t0 + tid) * 16 + hv], bv = AB[(size_t)(t0 + tid) * 16 + 8 + hv];
        const float xx = av + P.in[21][hv]; const float sp = (xx > 20.f) ? xx : log1pf(expf(xx));
        float gv = -expf(P.in[20][hv]) * sp;
#pragma unroll
        for (int o = 1; o < 64; o <<= 1) { const float t = __shfl_up(gv, o); if (lane >= o) gv += t; }
        gcs[tid] = gv; bts[tid] = sigmoidf_(bv);
        if (tid == 63) WSP(float, WS_SMALL + SM_GG)[u] = expf(gv);
    }
    __syncthreads();
    if (tid < 384) {
        const int which = tid >> 7, d = tid & 127;
        const int col = (which == 0) ? (1024 + hq * 128 + d) : (which == 1) ? (1536 + hq * 128 + d) : (2048 + hv * 128 + d);
        const int ch = (which == 0) ? (hq * 128 + d) : (which == 1) ? (512 + hq * 128 + d) : (1024 + hv * 128 + d);
        const float* cw = P.in[19]; const float w0 = cw[ch], w1 = cw[2048 + ch], w2 = cw[4096 + ch], w3 = cw[6144 + ch];
        const bf16_t* src = Y0 + col;
        unsigned short xin[67];
#pragma unroll
        for (int i = 0; i < 67; ++i) { const int tt = t0 - 3 + i; const unsigned short xv = src[(size_t)(tt < 0 ? 0 : tt) * 4096]; xin[i] = (tt >= 0) ? xv : (unsigned short)0; }
#pragma unroll
        for (int t = 0; t < 64; ++t) {
            float y = w0 * bf2f(xin[t]) + w1 * bf2f(xin[t + 1]) + w2 * bf2f(xin[t + 2]) + w3 * bf2f(xin[t + 3]); y = siluf_(y);
            if (which < 2) tmp[(which * 64 + t) * 129 + d] = y; else vbT[d * 72 + t] = (bf16_t)f2bf(y * bts[t]);
        }
    }
    __syncthreads();
    {
        const int which = w >> 2; const float gl = gcs[63];
        for (int rr = 0; rr < 16; ++rr) {
            const int t = (w & 3) * 16 + rr; const float a = tmp[(which * 64 + t) * 129 + lane], b = tmp[(which * 64 + t) * 129 + lane + 64];
            const float ss = wave_sum(a * a + b * b); float rinv = rsqrtf(ss + EPS);
            if (which == 0) { rinv *= 0.08838834764831845f; qn[t * 136 + lane] = (bf16_t)f2bf(a * rinv); qn[t * 136 + lane + 64] = (bf16_t)f2bf(b * rinv); }
            else { const float ka = a * rinv, kb = b * rinv, gt = gcs[t]; const float e1 = bts[t] * __expf(gt), e2 = __expf(gl - gt);
                kn[t * 136 + lane] = (bf16_t)f2bf(ka); kn[t * 136 + lane + 64] = (bf16_t)f2bf(kb);
                kbgT[lane * 72 + t] = (bf16_t)f2bf(ka * e1); kbgT[(lane + 64) * 72 + t] = (bf16_t)f2bf(kb * e1);
                kdT[lane * 72 + t] = (bf16_t)f2bf(ka * e2); kdT[(lane + 64) * 72 + t] = (bf16_t)f2bf(kb * e2); }
        }
    }
    __syncthreads();
    {
        const int which = w >> 2, mt = w & 3;
        for (int nt = 0; nt < 4; ++nt) {
            const f32x4 acc = tile_mm<false>(which ? qn : kn, 136, kn, 136, mt * 16, nt * 16, 4, fr, fq);
#pragma unroll
            for (int r = 0; r < 4; ++r) { const int i = mt * 16 + fq * 4 + r, j = nt * 16 + fr;
                const float dec = (i >= j) ? __expf(gcs[i] - gcs[j]) : 0.f;
                if (which == 0) Lf[i * 64 + j] = (i > j) ? bts[i] * acc[r] * dec : 0.f;
                else At[i * 72 + j] = (bf16_t)f2bf((i >= j) ? acc[r] * dec : 0.f); }
        }
    }
    __syncthreads();
    if (w == 0) {
        LAS float* Tf = (LAS float*)(lds + 34816);
        LAS float* Xs = (LAS float*)(lds + 51200);
        {
            const int b = lane >> 4, c = lane & 15; float t[16];
#pragma unroll
            for (int i = 0; i < 16; ++i) {
                float acc = (i == c) ? 1.f : 0.f;
#pragma unroll
                for (int j = 0; j < i; ++j) acc -= Lf[(16 * b + i) * 64 + 16 * b + j] * t[j];
                t[i] = acc;
            }
#pragma unroll
            for (int i = 0; i < 16; ++i) Tf[(16 * b + i) * 64 + 16 * b + c] = t[i];
        }
        const int ri = lane & 15, kk = lane >> 4;
#pragma unroll
        for (int i = 1; i < 4; ++i)
#pragma unroll
            for (int j = 0; j < i; ++j) {
                f32x4 acc = (f32x4){0.f, 0.f, 0.f, 0.f};
#pragma unroll
                for (int k = j; k < i; ++k)
#pragma unroll
                    for (int sq = 0; sq < 4; ++sq) acc = __builtin_amdgcn_mfma_f32_16x16x4f32(Lf[(16 * i + ri) * 64 + 16 * k + 4 * sq + kk], Tf[(16 * k + 4 * sq + kk) * 64 + 16 * j + ri], acc, 0, 0, 0);
#pragma unroll
                for (int r = 0; r < 4; ++r) Xs[(kk * 4 + r) * 16 + ri] = acc[r];
                f32x4 a2 = (f32x4){0.f, 0.f, 0.f, 0.f};
#pragma unroll
                for (int sq = 0; sq < 4; ++sq) a2 = __builtin_amdgcn_mfma_f32_16x16x4f32(Tf[(16 * i + ri) * 64 + 16 * i + 4 * sq + kk], Xs[(4 * sq + kk) * 16 + ri], a2, 0, 0, 0);
#pragma unroll
                for (int r = 0; r < 4; ++r) Tf[(16 * i + kk * 4 + r) * 64 + 16 * j + ri] = -a2[r];
            }
#pragma unroll 8
        for (int i = 0; i < 64; ++i) { const float v = ((i >> 4) >= (lane >> 4)) ? Tf[i * 64 + lane] : 0.f; Tb[i * 72 + lane] = (bf16_t)f2bf(v); }
    }
    __syncthreads();
    {
        const int which = w >> 2, mt = w & 3;
        for (int nt = 0; nt < 8; ++nt) {
            const f32x4 acc = tile_mm<false>(Tb, 72, which ? kbgT : vbT, 72, mt * 16, nt * 16, 2, fr, fq);
            u32x2 o; o.x = pk2(acc[0], acc[1]); o.y = pk2(acc[2], acc[3]);
            *(LAS u32x2*)((which ? wT : uT) + (nt * 16 + fr) * 72 + mt * 16 + fq * 4) = o;
        }
    }
    __syncthreads();
    {
        bf16_t* Pg = WSP(bf16_t, WS_H) + (size_t)u * 16384; bf16_t* RTg = WSP(bf16_t, WS_RAW + 64 * MiB) + (size_t)u * 16384;
        bf16_t* QEg = WSP(bf16_t, WS_BIG + B_QE) + (size_t)u * 8192; bf16_t* OUg = WSP(bf16_t, WS_BIG + B_OU) + (size_t)u * 8192;
        for (int tile = w; tile < 192; tile += 8) {
            if (tile < 64) { const int mt = tile >> 3, nt = tile & 7; const f32x4 acc = tile_mm<true>(kdT, 72, wT, 72, mt * 16, nt * 16, 2, fr, fq);
                u32x2 o; o.x = pk2(acc[0], acc[1]); o.y = pk2(acc[2], acc[3]);
                *(u32x2*)(Pg + (((mt * 4 + (nt >> 1)) * 64 + ((nt & 1) * 2 + (fq >> 1)) * 16 + fr) * 8 + (fq & 1) * 4)) = o; }
            else if (tile < 128) { const int tt = tile - 64, mt = tt >> 3, nt = tt & 7; const f32x4 acc = tile_mm<true>(uT, 72, kdT, 72, mt * 16, nt * 16, 2, fr, fq);
                u32x2 o; o.x = pk2(acc[0], acc[1]); o.y = pk2(acc[2], acc[3]); *(u32x2*)(RTg + ((mt * 8 + nt) * 64 + lane) * 4) = o; }
            else if (tile < 160) { const int tt = tile - 128, mt = tt >> 3, nt = tt & 7; const f32x4 acc = tile_mm<true>(At, 72, wT, 72, mt * 16, nt * 16, 2, fr, fq);
                const int i = mt * 16 + fr; const float eg = __expf(gcs[i]); float q[4];
#pragma unroll
                for (int r = 0; r < 4; ++r) q[r] = bf2f(qn[i * 136 + nt * 16 + fq * 4 + r]) * eg - acc[r];
                u32x2 o; o.x = pk2(q[0], q[1]); o.y = pk2(q[2], q[3]);
                *(u32x2*)(QEg + (((mt * 4 + (nt >> 1)) * 64 + ((nt & 1) * 2 + (fq >> 1)) * 16 + fr) * 8 + (fq & 1) * 4)) = o; }
            else { const int tt = tile - 160, mt = tt >> 3, nt = tt & 7; const f32x4 acc = tile_mm<true>(At, 72, uT, 72, mt * 16, nt * 16, 2, fr, fq);
                u32x2 o; o.x = pk2(acc[0], acc[1]); o.y = pk2(acc[2], acc[3]); *(u32x2*)(OUg + ((nt * 4 + mt) * 64 + lane) * 4) = o; }
        }
    }
    __syncthreads();
}

struct GS { bf16x8 pf[4], qf[4]; u32x2 rt, ou; float gl; };
__device__ __forceinline__ void gs_load(GS& x, const bf16_t* Pg, const bf16_t* RTg, const bf16_t* QEg, const bf16_t* OUg, const float* GG, int hv, int n, int w, int fr, int fq, int dv0) {
    const size_t u = (size_t)hv * 256 + n;
#pragma unroll
    for (int ks = 0; ks < 4; ++ks) x.pf[ks] = *(const bf16x8*)(Pg + u * 16384 + ((w * 4 + ks) * 64 + fq * 16 + fr) * 8);
    x.rt = *(const u32x2*)(RTg + u * 16384 + (((dv0 >> 4) * 8 + w) * 64 + fq * 16 + fr) * 4);
    x.gl = GG[u];
    if (w < 4) {
#pragma unroll
        for (int ks = 0; ks < 4; ++ks) x.qf[ks] = *(const bf16x8*)(QEg + u * 8192 + ((w * 4 + ks) * 64 + fq * 16 + fr) * 8);
        x.ou = *(const u32x2*)(OUg + u * 8192 + (((dv0 >> 4) * 4 + w) * 64 + fq * 16 + fr) * 4);
    }
}
__device__ __forceinline__ void gdn_scan_wg(const Ctx& F, int hv, int sl) {
    const Params& P = *F.p;
    LAS bf16_t* Sb = (LAS bf16_t*)F.lds;
    const int lane = F.lane, w = F.wave, fr = lane & 15, fq = lane >> 4, dv0 = sl * 16;
    const bf16_t* Pg = WSP(bf16_t, WS_H); const bf16_t* RTg = WSP(bf16_t, WS_RAW + 64 * MiB);
    const bf16_t* QEg = WSP(bf16_t, WS_BIG + B_QE); const bf16_t* OUg = WSP(bf16_t, WS_BIG + B_OU);
    const float* GG = WSP(float, WS_SMALL + SM_GG); bf16_t* O = WSP(bf16_t, WS_RAW);
    for (int e = F.tid; e < 2 * 16 * 136; e += 512) Sb[e] = 0;
    f32x4 s = (f32x4){0.f, 0.f, 0.f, 0.f};
    int* prog = WSP(int, WS_SMALL + SM_PROG) + hv * 64; const bool publish = (sl == 0);
    constexpr int RS = 4;
    GS ring[RS];
#pragma unroll
    for (int i = 0; i < RS - 1; ++i) gs_load(ring[i], Pg, RTg, QEg, OUg, GG, hv, i, w, fr, fq, dv0);
    asm volatile("s_waitcnt lgkmcnt(0)" ::: "memory"); __builtin_amdgcn_s_barrier(); asm volatile("" ::: "memory");
    for (int n0 = 0; n0 < 256; n0 += 4 * RS) {
#pragma unroll
        for (int j = 0; j < 4 * RS; ++j) {
            const int n = n0 + j;
            if (n < 256) {
            const int cur = n & 1;
            { const int nn = (n + RS - 1 < 256) ? n + RS - 1 : 255; gs_load(ring[(j + RS - 1) % RS], Pg, RTg, QEg, OUg, GG, hv, nn, w, fr, fq, dv0); }
            const GS& x = ring[j % RS];
            if (publish && F.tid == 0) __hip_atomic_store(prog, n, __ATOMIC_RELAXED, __HIP_MEMORY_SCOPE_AGENT);
            bf16x8 sf[4];
#pragma unroll
            for (int ks = 0; ks < 4; ++ks) sf[ks] = *(const LAS bf16x8*)(Sb + cur * 2176 + fr * 136 + ks * 32 + fq * 8);
            f32x4 pacc = (f32x4){0.f, 0.f, 0.f, 0.f};
#pragma unroll
            for (int ks = 0; ks < 4; ++ks) pacc = mfma16(x.pf[ks], sf[ks], pacc);
            if (w < 4) {
                f32x4 oacc = (f32x4){__uint_as_float(x.ou.x << 16), __uint_as_float(x.ou.x & 0xffff0000u), __uint_as_float(x.ou.y << 16), __uint_as_float(x.ou.y & 0xffff0000u)};
#pragma unroll
                for (int ks = 0; ks < 4; ++ks) oacc = mfma16(sf[ks], x.qf[ks], oacc);
                { u32x2 ob; ob.x = pk2(oacc[0], oacc[1]); ob.y = pk2(oacc[2], oacc[3]); *(u32x2*)(O + ((size_t)(hv * 8 + (dv0 >> 4)) * SEQ + (n * 64 + w * 16 + fr)) * 16 + fq * 4) = ob; }
            }
            const f32x4 rv = (f32x4){__uint_as_float(x.rt.x << 16), __uint_as_float(x.rt.x & 0xffff0000u), __uint_as_float(x.rt.y << 16), __uint_as_float(x.rt.y & 0xffff0000u)};
            s = s * x.gl + rv - pacc;
            u32x2 o; o.x = pk2(s[0], s[1]); o.y = pk2(s[2], s[3]);
            *(LAS u32x2*)(Sb + (cur ^ 1) * 2176 + fr * 136 + w * 16 + fq * 4) = o;
            asm volatile("s_waitcnt lgkmcnt(0)" ::: "memory"); __builtin_amdgcn_s_barrier(); asm volatile("" ::: "memory");
            }
        }
    }
    asm volatile("s_waitcnt vmcnt(0)" ::: "memory");
}
__device__ __forceinline__ void gdn_warm_wg(const Ctx& F, int hv, int wi) {
    const Params& P = *F.p;
    const char* Pg = (const char*)WSP(bf16_t, WS_H); const char* RTg = (const char*)WSP(bf16_t, WS_RAW + 64 * MiB);
    const char* QEg = (const char*)WSP(bf16_t, WS_BIG + B_QE); const char* OUg = (const char*)WSP(bf16_t, WS_BIG + B_OU);
    int* prog = WSP(int, WS_SMALL + SM_PROG) + hv * 64;
    unsigned sum = 0;
    for (int n = F.wave; n < 256; n += 8) {
        int spins = 0;
        while (true) { const int p = __hip_atomic_load(prog, __ATOMIC_RELAXED, __HIP_MEMORY_SCOPE_AGENT); if (p + 12 >= n || ++spins > 4000) break; __builtin_amdgcn_s_sleep(16); }
        const size_t u = (size_t)hv * 256 + n;
#pragma unroll
        for (int i = 0; i < 3; ++i) { const int li = wi * 192 + i * 64 + F.lane;
            const char* a = (li < 256) ? (Pg + u * 32768 + (size_t)li * 128) : (li < 512) ? (RTg + u * 32768 + (size_t)(li - 256) * 128) : (li < 640) ? (QEg + u * 16384 + (size_t)(li - 512) * 128) : (OUg + u * 16384 + (size_t)(li - 640) * 128);
            sum += *(const volatile unsigned*)a; }
    }
    if (sum == 0x9e3779b9u) prog[32] = (int)sum;
}
__device__ __forceinline__ void gdn_finalize(const Ctx& F) {
    const Params& P = *F.p;
    const bf16_t* O = WSP(bf16_t, WS_RAW); const bf16_t* Y0 = WSP(bf16_t, WS_BIG + B_Y); bf16_t* CAT = WSP(bf16_t, WS_CAT);
    const int gw = F.bid * 8 + F.wave, NGW = F.G * 8, lane = F.lane, d0 = (lane & 7) * 16;
    float nw[16];
#pragma unroll
    for (int i = 0; i < 16; ++i) nw[i] = P.in[22][d0 + i];
    for (int row = gw; row < SEQ; row += NGW) {
        float o[16]; const u32x4* op = (const u32x4*)(O + ((size_t)lane * SEQ + row) * 16);
        float ss = 0.f;
        { const u32x4 a = op[0], b = op[1]; const unsigned ww[8] = {a.x, a.y, a.z, a.w, b.x, b.y, b.z, b.w};
#pragma unroll
          for (int i = 0; i < 8; ++i) { o[2 * i] = __uint_as_float(ww[i] << 16); o[2 * i + 1] = __uint_as_float(ww[i] & 0xffff0000u); ss += o[2 * i] * o[2 * i] + o[2 * i + 1] * o[2 * i + 1]; } }
        ss += __shfl_xor(ss, 1); ss += __shfl_xor(ss, 2); ss += __shfl_xor(ss, 4);
        const float rstd = rsqrtf(ss * (1.0f / 128.0f) + EPS);
        const u32x4* zp = (const u32x4*)(Y0 + (size_t)row * 4096 + 3072 + lane * 16); unsigned zz[8];
        { const u32x4 a = zp[0], b = zp[1]; zz[0] = a.x; zz[1] = a.y; zz[2] = a.z; zz[3] = a.w; zz[4] = b.x; zz[5] = b.y; zz[6] = b.z; zz[7] = b.w; }
        unsigned ov[8];
#pragma unroll
        for (int i = 0; i < 8; ++i) { const float z0 = __uint_as_float(zz[i] << 16), z1 = __uint_as_float(zz[i] & 0xffff0000u);
            ov[i] = pk2(o[2 * i] * rstd * nw[2 * i] * siluf_(z0), o[2 * i + 1] * rstd * nw[2 * i + 1] * siluf_(z1)); }
        u32x4* cp = (u32x4*)(CAT + (size_t)row * 2048 + 1024 + lane * 16);
        cp[0] = (u32x4){ov[0], ov[1], ov[2], ov[3]}; cp[1] = (u32x4){ov[4], ov[5], ov[6], ov[7]};
    }
}

__device__ __forceinline__ void gla_local_unit(const Ctx& F, int h, int n) {
    const Params& P = *F.p;
    LAS float* bc = (LAS float*)F.lds;
    LAS bf16_t* qt = (LAS bf16_t*)(F.lds + 65536);
    LAS bf16_t* kt = (LAS bf16_t*)(F.lds + 99328);
    LAS float* gl = (LAS float*)(F.lds + 133120);
    const int tid = F.tid, lane = F.lane, w = F.wave, fr = lane & 15, fq = lane >> 4, t0 = n * 64, u = h * 256 + n;
    const bf16_t* Y1 = WSP(bf16_t, WS_BIG + B_Y); const float* GLOW = WSP(float, WS_SMALL + SM_GLOW);
    bf16_t* QT = WSP(bf16_t, WS_H) + (size_t)u * 16384; bf16_t* KDT = WSP(bf16_t, WS_H + 32 * MiB) + (size_t)u * 16384;
    bf16_t* ATT = WSP(bf16_t, WS_BIG + B_ATT) + (size_t)u * 4096; bf16_t* VT = WSP(bf16_t, WS_BIG + B_VT) + (size_t)u * 32768;
    float* GLAST = WSP(float, WS_SMALL + SM_GLAST);
    for (int e = tid; e < 1024; e += 512) gl[e] = GLOW[(size_t)t0 * 16 + e];
    __syncthreads();
    if (tid < 256) {
        const int dk = tid, col = h * 256 + dk; float w2[16];
#pragma unroll
        for (int j = 0; j < 16; ++j) w2[j] = P.in[34][j * 1024 + col];
        const float gb = P.in[35][col]; float run = 0.f;
        for (int t = 0; t < 64; ++t) { float x = gb;
#pragma unroll
            for (int j = 0; j < 16; ++j) x += gl[t * 16 + j] * w2[j];
            const float ls = fminf(x, 0.f) - __logf(1.0f + __expf(-fabsf(x)));
            run += ls * 0.0625f; bc[t * 256 + dk] = run; }
    } else {
        for (int rep = 0; rep < 2; ++rep) { const int dv = (tid - 256) + rep * 256; const bf16_t* src = Y1 + (size_t)t0 * 6144 + 2048 + h * 512 + dv;
            unsigned short x[64];
#pragma unroll
            for (int j = 0; j < 64; ++j) x[j] = src[(size_t)j * 6144];
#pragma unroll
            for (int c0 = 0; c0 < 64; c0 += 8) {
                u32x4 o; o.x = x[c0] | ((unsigned)x[c0 + 1] << 16); o.y = x[c0 + 2] | ((unsigned)x[c0 + 3] << 16); o.z = x[c0 + 4] | ((unsigned)x[c0 + 5] << 16); o.w = x[c0 + 6] | ((unsigned)x[c0 + 7] << 16);
                *(u32x4*)(VT + ((((dv >> 4) * 2 + (c0 >> 5)) * 64 + ((c0 >> 3) & 3) * 16 + (dv & 15)) * 8)) = o; } }
    }
    __syncthreads();
    for (int item = tid; item < 2048; item += 512) {
        const int dk = item & 255, tb = item >> 8; const float bl = bc[63 * 256 + dk]; float kd[8]; unsigned short qr[8], kr[8];
#pragma unroll
        for (int j = 0; j < 8; ++j) { const int t = tb * 8 + j; qr[j] = Y1[(size_t)(t0 + t) * 6144 + h * 256 + dk]; kr[j] = Y1[(size_t)(t0 + t) * 6144 + 1024 + h * 256 + dk]; }
#pragma unroll
        for (int j = 0; j < 8; ++j) { const int t = tb * 8 + j; const float b = bc[t * 256 + dk];
            const float q = bf2f(qr[j]) * 0.0625f, k = bf2f(kr[j]);
            qt[t * 264 + dk] = (bf16_t)f2bf(q * __expf(b));
            kt[t * 264 + dk] = (bf16_t)f2bf(k * __expf(-b)); kd[j] = k * __expf(bl - b); }
        u32x4 o; o.x = pk2(kd[0], kd[1]); o.y = pk2(kd[2], kd[3]); o.z = pk2(kd[4], kd[5]); o.w = pk2(kd[6], kd[7]);
        *(u32x4*)(KDT + ((((dk >> 4) * 2 + (tb >> 2)) * 64 + (tb & 3) * 16 + (dk & 15)) * 8)) = o;
        if (tb == 7) GLAST[(size_t)n * 1024 + h * 256 + dk] = __expf(bl);
    }
    __syncthreads();
    for (int t2 = 0; t2 < 2; ++t2) { const int tile = w * 2 + t2, mt = tile >> 2, nt = tile & 3;
        const f32x4 acc = tile_mm<true>(qt, 264, kt, 264, mt * 16, nt * 16, 8, fr, fq);
        const int i = mt * 16 + fr; float a[4];
#pragma unroll
        for (int r = 0; r < 4; ++r) { const int j = nt * 16 + fq * 4 + r; a[r] = (j <= i) ? acc[r] : 0.f; }
        u32x2 o; o.x = pk2(a[0], a[1]); o.y = pk2(a[2], a[3]); *(u32x2*)(ATT + (((mt * 2 + (nt >> 1)) * 64 + ((nt & 1) * 2 + (fq >> 1)) * 16 + fr) * 8 + (fq & 1) * 4)) = o; }
    for (int piece = tid; piece < 2048; piece += 512) { const int w_ = piece >> 8, mt = (piece >> 6) & 3, ln = piece & 63, fr_ = ln & 15, fq_ = ln >> 4;
        const LAS bf16_t* qp = qt + (mt * 16 + fr_) * 264 + w_ * 32 + fq_ * 4; const u32x2 lo = *(const LAS u32x2*)qp, hi = *(const LAS u32x2*)(qp + 16);
        *(u32x4*)(QT + (size_t)piece * 8) = (u32x4){lo.x, lo.y, hi.x, hi.y}; }
    __syncthreads();
}
struct LS { bf16x8 qf[4], kf[2][2], vf[2], af[2]; f32x4 g0, g1; };
__device__ __forceinline__ void ls_load(LS& x, const bf16_t* QT, const bf16_t* KDTb, const bf16_t* ATTb, const bf16_t* VTb, const float* GLAST, int h, int n, int w, int fr, int fq, int dv0, int dk0) {
    const size_t u = (size_t)h * 256 + n; const int lane = fq * 16 + fr;
#pragma unroll
    for (int mt = 0; mt < 4; ++mt) x.qf[mt] = *(const bf16x8*)(QT + u * 16384 + ((w * 4 + mt) * 64 + lane) * 8);
#pragma unroll
    for (int tl = 0; tl < 2; ++tl)
#pragma unroll
        for (int ks = 0; ks < 2; ++ks) x.kf[tl][ks] = *(const bf16x8*)(KDTb + u * 16384 + (((2 * w + tl) * 2 + ks) * 64 + lane) * 8);
#pragma unroll
    for (int ks = 0; ks < 2; ++ks) x.vf[ks] = *(const bf16x8*)(VTb + u * 32768 + (((dv0 >> 4) * 2 + ks) * 64 + lane) * 8);
    x.g0 = *(const f32x4*)(GLAST + (size_t)n * 1024 + h * 256 + dk0 + fq * 4); x.g1 = *(const f32x4*)(GLAST + (size_t)n * 1024 + h * 256 + dk0 + 16 + fq * 4);
    if (w < 4) {
#pragma unroll
        for (int ks = 0; ks < 2; ++ks) x.af[ks] = *(const bf16x8*)(ATTb + u * 4096 + ((w * 2 + ks) * 64 + lane) * 8);
    }
}
__device__ __forceinline__ void gla_scan_wg(const Ctx& F, int h, int sl) {
    const Params& P = *F.p;
    LAS float* OP = (LAS float*)F.lds;
    const int tid = F.tid, lane = F.lane, w = F.wave, fr = lane & 15, fq = lane >> 4, dv0 = sl * 16, dk0 = w * 32;
    const bf16_t* QT = WSP(bf16_t, WS_H); const bf16_t* KDTb = WSP(bf16_t, WS_H + 32 * MiB);
    const bf16_t* ATTb = WSP(bf16_t, WS_BIG + B_ATT); const bf16_t* VTb = WSP(bf16_t, WS_BIG + B_VT);
    const float* GLAST = WSP(float, WS_SMALL + SM_GLAST); bf16_t* O = WSP(bf16_t, WS_RAW);
    f32x4 s0 = (f32x4){0.f, 0.f, 0.f, 0.f}, s1 = s0;
    int* prog = WSP(int, WS_SMALL + SM_PROG) + (8 + (F.bid & 7)) * 64; const bool publish = (sl < 2);
    LS ring[3];
    ls_load(ring[0], QT, KDTb, ATTb, VTb, GLAST, h, 0, w, fr, fq, dv0, dk0);
    ls_load(ring[1], QT, KDTb, ATTb, VTb, GLAST, h, 1, w, fr, fq, dv0, dk0);
    for (int n0 = 0; n0 < 256; n0 += 12) {
#pragma unroll
        for (int j = 0; j < 12; ++j) {
            const int n = n0 + j;
            if (n < 256) {
                const int t0 = n * 64, buf = n & 1;
                { const int nn = (n + 2 < 256) ? n + 2 : 255; ls_load(ring[(j + 2) % 3], QT, KDTb, ATTb, VTb, GLAST, h, nn, w, fr, fq, dv0, dk0); }
                const LS& x = ring[j % 3];
                if (publish && tid == 0) __hip_atomic_store(prog, n, __ATOMIC_RELAXED, __HIP_MEMORY_SCOPE_AGENT);
                u32x4 sp; sp.x = pk2(s0[0], s0[1]); sp.y = pk2(s0[2], s0[3]); sp.z = pk2(s1[0], s1[1]); sp.w = pk2(s1[2], s1[3]);
                const bf16x8 sf = __builtin_bit_cast(bf16x8, sp);
                f32x4 op[4];
#pragma unroll
                for (int mt = 0; mt < 4; ++mt) op[mt] = mfma16(sf, x.qf[mt], (f32x4){0.f, 0.f, 0.f, 0.f});
                if (w < 4) {
                    f32x4 oi = (f32x4){0.f, 0.f, 0.f, 0.f};
#pragma unroll
                    for (int ks = 0; ks < 2; ++ks) oi = mfma16(x.vf[ks], x.af[ks], oi);
#pragma unroll
                    for (int mt = 0; mt < 4; ++mt) if (mt == w) op[mt] += oi;
                }
#pragma unroll
                for (int mt = 0; mt < 4; ++mt) *(LAS f32x4*)(OP + ((buf * 8 + w) * 64 + mt * 16 + fr) * 16 + fq * 4) = op[mt];
                f32x4 u0 = (f32x4){0.f, 0.f, 0.f, 0.f}, u1 = u0;
#pragma unroll
                for (int ks = 0; ks < 2; ++ks) { u0 = mfma16(x.kf[0][ks], x.vf[ks], u0); u1 = mfma16(x.kf[1][ks], x.vf[ks], u1); }
                s0 = s0 * x.g0 + u0; s1 = s1 * x.g1 + u1;
                asm volatile("s_waitcnt lgkmcnt(0)" ::: "memory"); __builtin_amdgcn_s_barrier(); asm volatile("" ::: "memory");
                { const int e = tid * 2; float a = 0.f, b = 0.f;
#pragma unroll
                    for (int ww = 0; ww < 8; ++ww) { const f32x2 xx = *(const LAS f32x2*)(OP + (buf * 8 + ww) * 1024 + e); a += xx[0]; b += xx[1]; }
                    *(unsigned*)(O + ((size_t)(h * 32 + (dv0 >> 4)) * SEQ + t0) * 16 + e) = pk2(a, b); }
            }
        }
    }
    asm volatile("s_waitcnt vmcnt(0)" ::: "memory");
}
__device__ __forceinline__ void gla_warm_wg(const Ctx& F, int xcd, int wi) {
    const Params& P = *F.p;
    const int h = xcd & 3;
    const char* QT = (const char*)WSP(bf16_t, WS_H); const char* KDTb = (const char*)WSP(bf16_t, WS_H + 32 * MiB);
    const char* ATTb = (const char*)WSP(bf16_t, WS_BIG + B_ATT); const char* VTb = (const char*)WSP(bf16_t, WS_BIG + B_VT);
    int* prog = WSP(int, WS_SMALL + SM_PROG) + (8 + xcd) * 64;
    unsigned sum = 0;
    for (int n = F.wave; n < 256; n += 8) {
        int spins = 0;
        while (true) { const int p = __hip_atomic_load(prog, __ATOMIC_RELAXED, __HIP_MEMORY_SCOPE_AGENT); if (p + 12 >= n || ++spins > 4000) break; __builtin_amdgcn_s_sleep(16); }
        const size_t u = (size_t)h * 256 + n;
#pragma unroll
        for (int i = 0; i < 5; ++i) { const int li = wi * 272 + i * 64 + F.lane;
            if (i * 64 + F.lane < 272) {
                const char* a = (li < 256) ? (QT + u * 32768 + (size_t)li * 128) : (li < 512) ? (KDTb + u * 32768 + (size_t)(li - 256) * 128) : (li < 576) ? (ATTb + u * 8192 + (size_t)(li - 512) * 128) : (VTb + u * 65536 + (size_t)(li - 576) * 128);
                sum += *(const volatile unsigned*)a; } }
    }
    if (sum == 0x9e3779b9u) prog[32] = (int)sum;
}
__device__ __forceinline__ void gla_finalize(const Ctx& F) {
    const Params& P = *F.p;
    const bf16_t* O = WSP(bf16_t, WS_RAW); const bf16_t* Y1 = WSP(bf16_t, WS_BIG + B_Y); bf16_t* CAT = WSP(bf16_t, WS_CAT);
    const int gw = F.bid * 8 + F.wave, NGW = F.G * 8, lane = F.lane, d0 = (lane & 15) * 32;
    for (int row = gw; row < SEQ; row += NGW) {
        f32x4 o[8]; const u32x4* op0 = (const u32x4*)(O + ((size_t)(lane * 2) * SEQ + row) * 16); const u32x4* op1 = (const u32x4*)(O + ((size_t)(lane * 2 + 1) * SEQ + row) * 16); float ss = 0.f;
        const u32x4 ob[4] = {op0[0], op0[1], op1[0], op1[1]};
#pragma unroll
        for (int i = 0; i < 8; ++i) { const u32x4 q4 = ob[i >> 1]; const unsigned w0 = (i & 1) ? q4.z : q4.x, w1 = (i & 1) ? q4.w : q4.y;
            o[i] = (f32x4){__uint_as_float(w0 << 16), __uint_as_float(w0 & 0xffff0000u), __uint_as_float(w1 << 16), __uint_as_float(w1 & 0xffff0000u)}; ss += (o[i][0] * o[i][0] + o[i][1] * o[i][1]) + (o[i][2] * o[i][2] + o[i][3] * o[i][3]); }
        ss += __shfl_xor(ss, 1); ss += __shfl_xor(ss, 2); ss += __shfl_xor(ss, 4); ss += __shfl_xor(ss, 8);
        const float rstd = rsqrtf(ss * (1.0f / 512.0f) + EPS);
        const u32x4* rp = (const u32x4*)(Y1 + (size_t)row * 6144 + 4096 + lane * 32); u32x4* cp = (u32x4*)(CAT + (size_t)row * 2048 + lane * 32);
#pragma unroll
        for (int i = 0; i < 4; ++i) { const u32x4 rv = rp[i]; const unsigned rr[4] = {rv.x, rv.y, rv.z, rv.w}; unsigned ov[4];
#pragma unroll
            for (int j = 0; j < 4; ++j) { const int e = i * 8 + j * 2; const float r0 = __uint_as_float(rr[j] << 16), r1 = __uint_as_float(rr[j] & 0xffff0000u);
                const float x0 = o[e >> 2][e & 3], x1 = o[(e + 1) >> 2][(e + 1) & 3];
                ov[j] = pk2(x0 * rstd * P.in[36][d0 + e] * siluf_(r0), x1 * rstd * P.in[36][d0 + e + 1] * siluf_(r1)); }
            cp[i] = (u32x4){ov[0], ov[1], ov[2], ov[3]}; }
    }
}

__global__ void __launch_bounds__(512, 2) fwd_megakernel(Params prm) {
    extern __shared__ __attribute__((aligned(16))) unsigned char lds_raw[];
    Ctx F; F.lds = (LAS unsigned char*)lds_raw; F.tid = threadIdx.x; F.lane = F.tid & 63; F.wave = __builtin_amdgcn_readfirstlane(F.tid >> 6); F.G = gridDim.x; F.bid = blockIdx.x; F.p = &prm;
    const Params& P = prm;
    const int lo = P.ph_lo, hi = P.ph_hi;
    bf16_t* Wb = WSP(bf16_t, WS_W);
#define WPTR(off) ((const bf16_t*)((const char*)Wb + (off)))
#define PHASE(k) if (lo <= (k) && (k) < hi)
#define SEAM(k) if (lo <= (k) && (k) + 1 < hi) { cg::this_grid().sync(); }
    PHASE(0) { phase_prologue(F); } SEAM(0)
    PHASE(1) { RowCfg c{0, 0, 0, 0, 4, 2048, 0, 8, 4112, 4096, P.in[0], WSP(float, WS_SMALL + SM_AB)}; row_phase<false, true, true>(F, c); } SEAM(1)
    PHASE(2) { pg8::Gemm g{WSP(bf16_t, WS_H), WPTR(W_IN0), SEQ, 4096, 2048}; pg8::StaticOrder S; S.init(SEQ, 4096, F.G, F.bid); pg8::EpiIn0 E{WSP(bf16_t, WS_BIG + B_Y), 4096, WSP(bf16_t, WS_BIG + B_UG)}; pg8::gemm_phase(F.lds, g, S, E); } SEAM(2)
    PHASE(3) { if (F.bid == 0 && F.tid < 8) WSP(int, WS_SMALL + SM_PROG)[F.tid * 64] = 0; for (int un = F.bid; un < 2048; un += F.G) gdn_local_unit(F, un & 7, un >> 3); s5_wu_phase(F); } SEAM(3)
    PHASE(4) { if (F.bid < 64) { if (P.mode4 != 2) gdn_scan_wg(F, F.bid & 7, F.bid >> 3); } else if (F.bid < 128) { if (P.mode4 != 1) s5_group_phase(F, F.bid - 64); } else if (F.bid < 224) { if (P.mode4 != 2) ada_gemv_layer1_idle(F, 128, 224); } else gdn_warm_wg(F, F.bid & 7, (F.bid - 224) >> 3); } SEAM(4)
    PHASE(5) { pg8::Gemm g{WSP(bf16_t, WS_BIG + B_YG), WPTR(W_GLU), SEQ, 1024, 1024}; pg8::StaticOrder S; S.init(SEQ, 1024, F.G, F.bid);
               pg8::EpiGlu E{WSP(bf16_t, WS_CAT), 2048, WSP(bf16_t, WS_BIG + B_YG), 1024, P.in[18]}; pg8::gemm_phase(F.lds, g, S, E); gdn_finalize(F); } SEAM(5)
    PHASE(6) { pg8::Gemm g{WSP(bf16_t, WS_CAT), WPTR(W_OUT0), SEQ, 2048, 2048}; pg8::StaticOrder S; S.init(SEQ, 2048, F.G, F.bid); pg8::EpiRaw E{WSP(bf16_t, WS_RAW), 2048, WSP(float, WS_SMALL + SM_SSQ)}; pg8::gemm_phase(F.lds, g, S, E); } SEAM(6)
    PHASE(7) { RowCfg c{0, 4096, 5, 0, 6, 8192, 6144, 0, 0, 0, P.in[0], nullptr}; row_phase<true, true, false>(F, c); } SEAM(7)
    PHASE(8) { pg8::Gemm g{WSP(bf16_t, WS_H), WPTR(W_GU0), SEQ, 11264, 2048}; pg8::StaticOrder S; S.init(SEQ, 11264, F.G, F.bid); pg8::EpiSwiglu E{WSP(bf16_t, WS_BIG + B_HID), FFH}; pg8::gemm_phase(F.lds, g, S, E); } SEAM(8)
    PHASE(9) { pg8::Gemm g{WSP(bf16_t, WS_BIG + B_HID), WPTR(W_DN0), SEQ, 2048, FFH}; pg8::StaticOrder S; S.init(SEQ, 2048, F.G, F.bid); pg8::EpiRaw E{WSP(bf16_t, WS_RAW), 2048, WSP(float, WS_SMALL + SM_SSQ)}; pg8::gemm_phase(F.lds, g, S, E); } SEAM(9)
    PHASE(10) { RowCfg c{0, 10240, 7, 1, 29, 2048, 0, 33, 6160, 6144, P.out, WSP(float, WS_SMALL + SM_GLOW)};
                row_phase<true, true, true>(F, c); } SEAM(10)
    PHASE(11) { pg8::Gemm g{WSP(bf16_t, WS_H), WPTR(W_IN1), SEQ, 6144, 2048}; pg8::StaticOrder S; S.init(SEQ, 6144, F.G, F.bid); pg8::EpiBf16Store E{WSP(bf16_t, WS_BIG + B_Y), 6144}; pg8::gemm_phase(F.lds, g, S, E); } SEAM(11)
    PHASE(12) { if (F.bid == 0 && F.tid < 8) WSP(int, WS_SMALL + SM_PROG)[(8 + F.tid) * 64] = 0; for (int un = F.bid; un < 1024; un += F.G) gla_local_unit(F, un & 3, un >> 2); } SEAM(12)
    PHASE(13) { if (F.bid < 128) gla_scan_wg(F, F.bid & 3, F.bid >> 2); else if (F.bid < 224) convert_layer1_rest_idle(F, 128, 224); else gla_warm_wg(F, F.bid & 7, (F.bid - 224) >> 3); } SEAM(13)
    PHASE(14) { gla_finalize(F); } SEAM(14)
    PHASE(15) { pg8::Gemm g{WSP(bf16_t, WS_CAT), WPTR(W_OUT1), SEQ, 2048, 2048}; pg8::StaticOrder S; S.init(SEQ, 2048, F.G, F.bid); pg8::EpiRaw E{WSP(bf16_t, WS_RAW), 2048, WSP(float, WS_SMALL + SM_SSQ)}; pg8::gemm_phase(F.lds, g, S, E); } SEAM(15)
    PHASE(16) { RowCfg c{1, 4096, 30, 1, 31, 8192, 6144, 0, 0, 0, P.out, nullptr}; row_phase<true, true, false>(F, c); } SEAM(16)
    PHASE(17) { pg8::Gemm g{WSP(bf16_t, WS_H), WPTR(W_GU1), SEQ, 11264, 2048}; pg8::StaticOrder S; S.init(SEQ, 11264, F.G, F.bid); pg8::EpiSwiglu E{WSP(bf16_t, WS_BIG + B_HID), FFH}; pg8::gemm_phase(F.lds, g, S, E); } SEAM(17)
    PHASE(18) { pg8::Gemm g{WSP(bf16_t, WS_BIG + B_HID), WPTR(W_DN1), SEQ, 2048, FFH}; pg8::StaticOrder S; S.init(SEQ, 2048, F.G, F.bid); pg8::EpiRaw E{WSP(bf16_t, WS_RAW), 2048, WSP(float, WS_SMALL + SM_SSQ)}; pg8::gemm_phase(F.lds, g, S, E); } SEAM(18)
    PHASE(19) { RowCfg c{1, 10240, 32, 1, 0, 0, 0, 0, 0, 0, P.out, nullptr}; row_phase<true, false, false>(F, c); }
}

extern "C" void kernel_launch(void* const* d_in, const int* in_sizes, int n_in, void* d_out, int out_size, void* d_ws, size_t ws_size, hipStream_t stream) {
    static int grid = 0;
    if (grid == 0) {
        if (n_in != 41 || ws_size < WS_END) { fprintf(stderr, "kernel_launch: unexpected n_in %d / ws_size %zu (need %zu)\n", n_in, ws_size, (size_t)WS_END); grid = -1; return; }
        int dev = 0, cus = 0, per_cu = 0;
        hipGetDevice(&dev); hipDeviceGetAttribute(&cus, hipDeviceAttributeMultiprocessorCount, dev);
        if (hipFuncSetAttribute((const void*)fwd_megakernel, hipFuncAttributeMaxDynamicSharedMemorySize, LDS_BYTES) != hipSuccess) { fprintf(stderr, "kernel_launch: hipFuncSetAttribute failed\n"); grid = -1; return; }
        hipOccupancyMaxActiveBlocksPerMultiprocessor(&per_cu, (const void*)fwd_megakernel, 512, LDS_BYTES);
        (void)hipGetLastError();
        if (per_cu < 1) per_cu = 1;
        grid = cus * 1;
        fprintf(stderr, "kernel_launch: cus %d per_cu %d grid %d ws %zu\n", cus, per_cu, grid, ws_size);
    }
    if (grid < 0) return;
    Params p{};
    for (int i = 0; i < 41; ++i) p.in[i] = (const float*)d_in[i];
    p.out = (float*)d_out; p.ws = (unsigned char*)d_ws;
#if MK_SINGLE_LAUNCH
    p.ph_lo = 0; p.ph_hi = NPHASE;
    void* args[] = {&p};
    hipError_t e = hipLaunchCooperativeKernel((const void*)fwd_megakernel, dim3(grid), dim3(512), args, LDS_BYTES, stream);
    if (e != hipSuccess) fprintf(stderr, "cooperative launch failed: %s (grid %d)\n", hipGetErrorString(e), grid);
#else
    static const int HREP[NPHASE] = {1,1,1,1,1, 1,1,1,1,1, 1,1,1,1,1, 1,1,1,1,1};
    static const int M4[4] = {M4LIST};
    for (int ph = 0; ph < NPHASE; ++ph) for (int r = 0; r < HREP[ph]; ++r) {
        p.ph_lo = ph; p.ph_hi = ph + 1; p.mode4 = (ph == 4) ? M4[r] : 0;
        hipLaunchKernelGGL(fwd_megakernel, dim3(grid), dim3(512), LDS_BYTES, stream, p);
    }
#endif
}
```

```cpp
#include <hip/hip_runtime.h>
#include <hip/hip_cooperative_groups.h>
#include <cstdio>
#include <cstdint>
namespace cg = cooperative_groups;

#ifndef MK_SINGLE_LAUNCH
#define MK_SINGLE_LAUNCH 1
#define M4LIST 0,0,0,0
#endif

#define LAS __attribute__((address_space(3)))
typedef unsigned short bf16_t;
typedef short bf16x8 __attribute__((ext_vector_type(8)));
typedef float f32x4 __attribute__((ext_vector_type(4)));
typedef float f32x2 __attribute__((ext_vector_type(2)));
typedef unsigned u32x4 __attribute__((ext_vector_type(4)));
typedef unsigned u32x2 __attribute__((ext_vector_type(2)));

constexpr int SEQ = 16384, DM = 2048, FFH = 5632;
constexpr int NPHASE = 20;
constexpr float EPS = 1e-6f;
constexpr size_t MiB = 1ull << 20;
constexpr size_t WS_SMALL = 0, WS_W = 8 * MiB, WS_H = 108 * MiB, WS_RAW = 172 * MiB, WS_CAT = 300 * MiB, WS_BIG = 364 * MiB, WS_END = 684 * MiB;
constexpr size_t SM_MODP = 0;
constexpr size_t SM_AB = 1 * MiB;
constexpr size_t SM_GLOW = 2 * MiB;
constexpr size_t SM_SSQ = 3 * MiB;
constexpr size_t SM_A16 = 5 * MiB;
constexpr size_t SM_GG = 5 * MiB + 65536;
constexpr size_t SM_GLAST = 6 * MiB;
constexpr size_t SM_XBAR = 7 * MiB;
constexpr size_t SM_PROG = 5 * MiB + 131072;
constexpr size_t W_IN0 = 0, W_GLU = 24 * MiB, W_OUT0 = 26 * MiB, W_GU0 = 34 * MiB, W_DN0 = 78 * MiB;
constexpr size_t W_IN1 = 0, W_OUT1 = 24 * MiB, W_GU1 = 32 * MiB, W_DN1 = 76 * MiB;
constexpr size_t B_Y = 0;
constexpr size_t B_S5WT = 128 * MiB, B_S5KT = 132 * MiB, B_S5WU = 144 * MiB, B_S5XC = 176 * MiB;
constexpr size_t B_QE = 192 * MiB, B_OU = 224 * MiB, B_YG = 256 * MiB, B_UG = 288 * MiB;
constexpr size_t B_ATT = 192 * MiB, B_VT = 200 * MiB;
constexpr size_t B_HID = 0;
constexpr int LDS_BYTES = 163840;

struct Params { const float* in[41]; float* out; unsigned char* ws; int ph_lo, ph_hi, mode4, pad; };

__device__ __forceinline__ unsigned f2bf(float f) { unsigned u = __float_as_uint(f); return (u + 0x7fffu + ((u >> 16) & 1u)) >> 16; }
__device__ __forceinline__ float bf2f(unsigned short b) { return __uint_as_float(((unsigned)b) << 16); }
__device__ __forceinline__ unsigned pk2(float lo, float hi) { return f2bf(lo) | (f2bf(hi) << 16); }
__device__ __forceinline__ unsigned cvt_pk_bf16(float lo, float hi) { unsigned r; asm volatile("v_cvt_pk_bf16_f32 %0, %1, %2" : "=v"(r) : "v"(lo), "v"(hi)); return r; }
__device__ __forceinline__ float wave_sum(float v) {
#pragma unroll
    for (int o = 1; o < 64; o <<= 1) v += __shfl_xor(v, o);
    return v;
}
__device__ __forceinline__ float sigmoidf_(float x) { return __builtin_amdgcn_rcpf(1.0f + __expf(-x)); }
__device__ __forceinline__ float siluf_(float x) { return x * __builtin_amdgcn_rcpf(1.0f + __expf(-x)); }
__device__ __forceinline__ f32x4 mfma16(bf16x8 a, bf16x8 b, f32x4 c) { return __builtin_amdgcn_mfma_f32_16x16x32_bf16(a, b, c, 0, 0, 0); }

namespace pg8 {
constexpr int BM = 256, BK = 64, HALF = 128, HTB = HALF * BK * 2, STAGE_BYTES = 8 * HTB, NXCD = 8, WGM = 8;
__host__ __device__ __forceinline__ int lds_byte(int r, int c) { const int st = (r >> 4) * 2 + (c >> 5), rr = r & 15, cc = c & 31, ob = rr * 64 + cc * 2; return st * 1024 + (ob ^ (((ob >> 9) & 1) << 5)); }
__host__ __device__ __forceinline__ void stage_rc(int b, int& R, int& C) { const int st = b / 1024, sb = b % 1024, swz = sb ^ (((sb >> 9) & 1) << 5); R = (st >> 1) * 16 + swz / 64; C = (st & 1) * 32 + (swz % 64) / 2; }
__host__ __device__ __forceinline__ int perm32(int rho) { const int n = rho >> 4, i = rho & 15; return 8 * (i >> 2) + 4 * n + (i & 3); }
struct Unit { int pm, pn; };
struct Gemm { const bf16_t* A; const bf16_t* Bt; int M, N, K; };
struct StaticOrder {
    int nM, nN, nwg, G, c;
    __device__ __forceinline__ void init(int M, int N, int G_, int c_) { nM = M / BM; nN = N / BM; nwg = nM * nN; G = G_; c = c_; }
    __device__ bool next(int i, Unit& u) const {
        const long L = (long)i * G + c; if (L >= nwg) return false;
        int wgid = (int)L; { const int q = nwg / NXCD, r = nwg % NXCD, xcd = wgid % NXCD, off = wgid / NXCD; wgid = (xcd < r ? xcd * (q + 1) : r * (q + 1) + (xcd - r) * q) + off; }
        const int nig = WGM * nN, gid = wgid / nig, fm = gid * WGM, gsz = (nM - fm) < WGM ? (nM - fm) : WGM;
        u.pm = fm + ((wgid % nig) % gsz); u.pn = (wgid % nig) / gsz; return true;
    }
};
struct EpiBf16Store {
    static constexpr bool PERM = true;
    bf16_t* O; int ldc;
    __device__ __forceinline__ void operator()(const f32x4 (&acc)[2][2][4][2], const Unit& u, int wr, int wc, int fr, int fq) const {
        const int row0 = u.pm * BM + wr * 64 + fr, col0 = u.pn * BM + wc * 32 + 8 * fq;
#pragma unroll
        for (int ai = 0; ai < 2; ++ai)
#pragma unroll
            for (int m = 0; m < 4; ++m) { bf16_t* rowp = O + (size_t)(row0 + ai * HALF + m * 16) * ldc + col0;
#pragma unroll
                for (int bj = 0; bj < 2; ++bj) { const f32x4 v0 = acc[ai][bj][m][0], v1 = acc[ai][bj][m][1];
                    u32x4 w; w.x = cvt_pk_bf16(v0[0], v0[1]); w.y = cvt_pk_bf16(v0[2], v0[3]); w.z = cvt_pk_bf16(v1[0], v1[1]); w.w = cvt_pk_bf16(v1[2], v1[3]);
                    *(u32x4*)(rowp + bj * HALF) = w; } }
    }
};
struct EpiIn0 {
    static constexpr bool PERM = true;
    bf16_t* O; int ldc; bf16_t* UG;
    __device__ __forceinline__ void operator()(const f32x4 (&acc)[2][2][4][2], const Unit& u, int wr, int wc, int fr, int fq) const {
        const int row0 = u.pm * BM + wr * 64 + fr, col0 = u.pn * BM + wc * 32 + 8 * fq;
#pragma unroll
        for (int ai = 0; ai < 2; ++ai)
#pragma unroll
            for (int m = 0; m < 4; ++m) { const int r = row0 + ai * HALF + m * 16;
#pragma unroll
                for (int bj = 0; bj < 2; ++bj) { const f32x4 v0 = acc[ai][bj][m][0], v1 = acc[ai][bj][m][1]; const int col = col0 + bj * HALF;
                    u32x4 w; w.x = cvt_pk_bf16(v0[0], v0[1]); w.y = cvt_pk_bf16(v0[2], v0[3]); w.z = cvt_pk_bf16(v1[0], v1[1]); w.w = cvt_pk_bf16(v1[2], v1[3]);
                    bf16_t* dst = (u.pn < 4) ? (UG + ((size_t)(col >> 4) * SEQ + r) * 16 + (col & 15)) : (O + (size_t)r * ldc + col);
                    *(u32x4*)dst = w; } }
    }
};
struct EpiGlu {
    static constexpr bool PERM = true;
    bf16_t* O; int ldc; const bf16_t* Y; int ldy; const float* bias;
    __device__ __forceinline__ void operator()(const f32x4 (&acc)[2][2][4][2], const Unit& u, int wr, int wc, int fr, int fq) const {
        const int row0 = u.pm * BM + wr * 64 + fr, col0 = u.pn * BM + wc * 32 + 8 * fq;
        f32x4 bv[2][2];
#pragma unroll
        for (int bj = 0; bj < 2; ++bj)
#pragma unroll
            for (int n = 0; n < 2; ++n) bv[bj][n] = *(const f32x4*)(bias + col0 + bj * HALF + 4 * n);
#pragma unroll
        for (int ai = 0; ai < 2; ++ai)
#pragma unroll
            for (int m = 0; m < 4; ++m) { const size_t r = (size_t)(row0 + ai * HALF + m * 16);
#pragma unroll
                for (int bj = 0; bj < 2; ++bj) {
                    const u32x4 yv = *(const u32x4*)(Y + r * ldy + col0 + bj * HALF);
                    const f32x4 v0 = acc[ai][bj][m][0] + bv[bj][0], v1 = acc[ai][bj][m][1] + bv[bj][1];
                    float o[8];
                    const unsigned yy[4] = {yv.x, yv.y, yv.z, yv.w};
#pragma unroll
                    for (int j = 0; j < 4; ++j) { const float ylo = __uint_as_float(yy[j] << 16), yhi = __uint_as_float(yy[j] & 0xffff0000u);
                        const float a0 = (j < 2) ? v0[2 * j] : v1[2 * j - 4], a1 = (j < 2) ? v0[2 * j + 1] : v1[2 * j - 3];
                        o[2 * j] = ylo * sigmoidf_(a0); o[2 * j + 1] = yhi * sigmoidf_(a1); }
                    u32x4 w; w.x = cvt_pk_bf16(o[0], o[1]); w.y = cvt_pk_bf16(o[2], o[3]); w.z = cvt_pk_bf16(o[4], o[5]); w.w = cvt_pk_bf16(o[6], o[7]);
                    *(u32x4*)(O + r * ldc + col0 + bj * HALF) = w; } }
    }
};
struct EpiSwiglu {
    static constexpr bool PERM = true;
    bf16_t* O; int ldc;
    __device__ __forceinline__ void operator()(const f32x4 (&acc)[2][2][4][2], const Unit& u, int wr, int wc, int fr, int fq) const {
        const int row0 = u.pm * BM + wr * 64 + fr, col0 = u.pn * HALF + wc * 32 + 8 * fq;
#pragma unroll
        for (int ai = 0; ai < 2; ++ai)
#pragma unroll
            for (int m = 0; m < 4; ++m) { bf16_t* rowp = O + (size_t)(row0 + ai * HALF + m * 16) * ldc + col0;
                float o[8];
#pragma unroll
                for (int n = 0; n < 2; ++n)
#pragma unroll
                    for (int j = 0; j < 4; ++j) { const float g = acc[ai][0][m][n][j], up = acc[ai][1][m][n][j]; o[4 * n + j] = siluf_(g) * up; }
                u32x4 w; w.x = cvt_pk_bf16(o[0], o[1]); w.y = cvt_pk_bf16(o[2], o[3]); w.z = cvt_pk_bf16(o[4], o[5]); w.w = cvt_pk_bf16(o[6], o[7]);
                *(u32x4*)rowp = w; }
    }
};
struct EpiRaw {
    static constexpr bool PERM = true;
    bf16_t* C; int ldc; float* ssq;
    __device__ __forceinline__ void operator()(const f32x4 (&acc)[2][2][4][2], const Unit& u, int wr, int wc, int fr, int fq) const {
        const int row0 = u.pm * BM + wr * 64 + fr, col0 = u.pn * BM + wc * 32 + 8 * fq;
#pragma unroll
        for (int ai = 0; ai < 2; ++ai)
#pragma unroll
            for (int m = 0; m < 4; ++m) { const int r = row0 + ai * HALF + m * 16; bf16_t* rowp = C + (size_t)r * ldc + col0; float s = 0.f;
#pragma unroll
                for (int bj = 0; bj < 2; ++bj) { const f32x4 v0 = acc[ai][bj][m][0], v1 = acc[ai][bj][m][1];
                    s += (v0[0] * v0[0] + v0[1] * v0[1]) + (v0[2] * v0[2] + v0[3] * v0[3]) + (v1[0] * v1[0] + v1[1] * v1[1]) + (v1[2] * v1[2] + v1[3] * v1[3]);
                    u32x4 w; w.x = cvt_pk_bf16(v0[0], v0[1]); w.y = cvt_pk_bf16(v0[2], v0[3]); w.z = cvt_pk_bf16(v1[0], v1[1]); w.w = cvt_pk_bf16(v1[2], v1[3]);
                    *(u32x4*)(rowp + bj * HALF) = w; }
                s += __shfl_xor(s, 16); s += __shfl_xor(s, 32);
                if (fq == 0) ssq[(size_t)r * 32 + u.pn * 4 + wc] = s; }
    }
};

template <class Epi>
__device__ __forceinline__ void gemm_phase(LAS unsigned char* lds, const Gemm g, const StaticOrder& S, const Epi& E) {
    const int tid = threadIdx.x, wid = __builtin_amdgcn_readfirstlane(tid >> 6), lane = tid & 63, wr = wid >> 2, wc = wid & 3, fr = lane & 15, fq = lane >> 4;
    const int K = g.K, nt = K / BK;
    unsigned voffA[2], voffB[2];
#pragma unroll
    for (int i = 0; i < 2; ++i) { int R, C; stage_rc(tid * 16 + i * 8192, R, C); const int Rb = Epi::PERM ? ((R & ~31) + perm32(R & 31)) : R;
        voffA[i] = (unsigned)(R * K + C) * 2u; voffB[i] = (unsigned)(Rb * K + C) * 2u; }
    const size_t kstep = (size_t)(BK * 2);
    const size_t hstep = (size_t)HALF * K * 2;
    const size_t tstep = 2 * hstep;
    const unsigned ldsw = (unsigned)wid * 1024u;
    const int aoff = lds_byte(wr * 64 + fr, fq * 8), boff = lds_byte(wc * 32 + fr, fq * 8);
#define PG8_SA(b, h) (((b) * 2 + (h)) * HTB)
#define PG8_SB(b, h) ((4 + (b) * 2 + (h)) * HTB)
#define PG8_STAGE(bufoff, gbase, voff) do { _Pragma("unroll") for (int _i = 0; _i < 2; ++_i) \
        __builtin_amdgcn_global_load_lds((const unsigned*)((const char*)(gbase) + (voff)[_i]), (LAS unsigned*)(lds + (bufoff) + ldsw + _i * 8192), 16, 0, 0); } while (0)
#define PG8_LDA(dst, b, h) do { _Pragma("unroll") for (int m = 0; m < 4; ++m) _Pragma("unroll") for (int k = 0; k < 2; ++k) dst[m][k] = *(const LAS bf16x8*)(lds + PG8_SA(b, h) + aoff + m * 2048 + k * 1024); } while (0)
#define PG8_LDB(dst, b, h) do { _Pragma("unroll") for (int n = 0; n < 2; ++n) _Pragma("unroll") for (int k = 0; k < 2; ++k) dst[n][k] = *(const LAS bf16x8*)(lds + PG8_SB(b, h) + boff + n * 2048 + k * 1024); } while (0)
#define PG8_MMA(ai, bj, At, Bt) do { __builtin_amdgcn_s_setprio(1); _Pragma("unroll") for (int m = 0; m < 4; ++m) _Pragma("unroll") for (int n = 0; n < 2; ++n) _Pragma("unroll") for (int k = 0; k < 2; ++k) \
        acc[ai][bj][m][n] = __builtin_amdgcn_mfma_f32_16x16x32_bf16(Bt[n][k], At[m][k], acc[ai][bj][m][n], 0, 0, 0); __builtin_amdgcn_s_setprio(0); } while (0)
#define PG8_WAIT_V(n) asm volatile("s_waitcnt vmcnt(" #n ")" ::: "memory")
#define PG8_WAIT_L(n) asm volatile("s_waitcnt lgkmcnt(" #n ")" ::: "memory")
#define PG8_BAR __builtin_amdgcn_s_barrier()
#define PG8_SCHED __builtin_amdgcn_sched_barrier(0)
    Unit cur, nxt; int ui = 0;
    if (!S.next(0, cur)) return;
    f32x4 acc[2][2][4][2];
#pragma unroll
    for (int a = 0; a < 2; ++a)
#pragma unroll
        for (int b = 0; b < 2; ++b)
#pragma unroll
            for (int m = 0; m < 4; ++m)
#pragma unroll
                for (int n = 0; n < 2; ++n) acc[a][b][m][n] = (f32x4){0.f, 0.f, 0.f, 0.f};
    bf16x8 At[4][2], B0[2][2], B1[2][2];
    const char* cA = (const char*)g.A + (size_t)cur.pm * tstep; const char* cB = (const char*)g.Bt + (size_t)cur.pn * tstep;
    PG8_STAGE(PG8_SB(0, 0), cB, voffB); PG8_STAGE(PG8_SB(0, 1), cB + hstep, voffB); PG8_STAGE(PG8_SA(0, 0), cA, voffA); PG8_STAGE(PG8_SA(0, 1), cA + hstep, voffA);
    if (wr == 1) PG8_BAR;
    PG8_WAIT_V(2); PG8_BAR;
    PG8_STAGE(PG8_SB(1, 0), cB + kstep, voffB); PG8_STAGE(PG8_SA(1, 0), cA + kstep, voffA); PG8_STAGE(PG8_SB(1, 1), cB + hstep + kstep, voffB);
    PG8_WAIT_V(6); PG8_BAR;
    for (;;) {
        const bool has_next = S.next(ui + 1, nxt);
        const char* nA = has_next ? (const char*)g.A + (size_t)nxt.pm * tstep : cA; const char* nB = has_next ? (const char*)g.Bt + (size_t)nxt.pn * tstep : cB;
        for (int t = 0; t < nt; t += 2) {
            const bool last = (t == nt - 2);
            const char* a1 = cA + (size_t)(t + 1) * kstep;
            const char* a2 = last ? nA : cA + (size_t)(t + 2) * kstep; const char* b2 = last ? nB : cB + (size_t)(t + 2) * kstep;
            const char* a3 = a2 + kstep; const char* b3 = b2 + kstep;
            PG8_LDB(B0, 0, 0); PG8_LDB(B1, 0, 1); PG8_SCHED; PG8_LDA(At, 0, 0); PG8_STAGE(PG8_SA(1, 1), a1 + hstep, voffA);
            PG8_WAIT_V(8); PG8_WAIT_L(0); PG8_BAR; PG8_MMA(0, 0, At, B0); PG8_MMA(0, 1, At, B1); PG8_BAR; PG8_SCHED;
            PG8_LDA(At, 0, 1); PG8_STAGE(PG8_SB(0, 0), b2, voffB); PG8_STAGE(PG8_SB(0, 1), b2 + hstep, voffB); PG8_STAGE(PG8_SA(0, 0), a2, voffA);
            PG8_WAIT_V(8); PG8_WAIT_L(0); PG8_BAR; PG8_MMA(1, 0, At, B0); PG8_MMA(1, 1, At, B1); PG8_BAR; PG8_SCHED;
            PG8_LDB(B0, 1, 0); PG8_LDB(B1, 1, 1); PG8_SCHED; PG8_LDA(At, 1, 0); PG8_STAGE(PG8_SA(0, 1), a2 + hstep, voffA);
            PG8_WAIT_V(8); PG8_WAIT_L(0); PG8_BAR; PG8_MMA(0, 0, At, B0); PG8_MMA(0, 1, At, B1); PG8_BAR; PG8_SCHED;
            PG8_LDA(At, 1, 1); PG8_STAGE(PG8_SB(1, 0), b3, voffB); PG8_STAGE(PG8_SB(1, 1), b3 + hstep, voffB); PG8_STAGE(PG8_SA(1, 0), a3, voffA);
            PG8_WAIT_V(8); PG8_WAIT_L(0); PG8_BAR; PG8_MMA(1, 0, At, B0); PG8_MMA(1, 1, At, B1); PG8_BAR; PG8_SCHED;
        }
        if (wr == 0) PG8_BAR;
        E(acc, cur, wr, wc, fr, fq);
        if (!has_next) break;
#pragma unroll
        for (int a = 0; a < 2; ++a)
#pragma unroll
            for (int b = 0; b < 2; ++b)
#pragma unroll
                for (int m = 0; m < 4; ++m)
#pragma unroll
                    for (int n = 0; n < 2; ++n) acc[a][b][m][n] = (f32x4){0.f, 0.f, 0.f, 0.f};
        cur = nxt; cA = nA; cB = nB; ++ui;
        if (wr == 1) PG8_BAR;
    }
    PG8_WAIT_V(0);
    PG8_BAR;
#undef PG8_SA
#undef PG8_SB
#undef PG8_STAGE
#undef PG8_LDA
#undef PG8_LDB
#undef PG8_MMA
#undef PG8_WAIT_V
#undef PG8_WAIT_L
#undef PG8_BAR
#undef PG8_SCHED
}
}

struct Ctx {
    LAS unsigned char* lds;
    int tid, lane, wave, G, bid;
    const Params* p;
};
#define WSP(T, off) ((T*)(P.ws + (off)))

template <bool SWAP>
__device__ __forceinline__ f32x4 tile_mm(const LAS bf16_t* A, int lda, const LAS bf16_t* B, int ldb, int m0, int n0, int ksteps, int fr, int fq) {
    f32x4 acc = (f32x4){0.f, 0.f, 0.f, 0.f};
    for (int ks = 0; ks < ksteps; ++ks) {
        const bf16x8 a = *(const LAS bf16x8*)(A + (m0 + fr) * lda + ks * 32 + fq * 8);
        const bf16x8 b = *(const LAS bf16x8*)(B + (n0 + fr) * ldb + ks * 32 + fq * 8);
        acc = SWAP ? mfma16(b, a, acc) : mfma16(a, b, acc);
    }
    return acc;
}

__device__ __forceinline__ void transpose_item(const float* W, int K, int Nsrc, int c0, bf16_t* WT, int mode, LAS float* scr, int kb, int nb, int lane) {
    const int k0 = 64 * kb, n0 = 32 * nb;
#pragma unroll 8
    for (int i = 0; i < 32; ++i) { const int kk = 2 * i + (lane >> 5); scr[kk * 33 + (lane & 31)] = W[(size_t)(k0 + kk) * Nsrc + c0 + n0 + (lane & 31)]; }
    asm volatile("s_waitcnt lgkmcnt(0)" ::: "memory");
    const int c = lane & 7;
#pragma unroll
    for (int j = 0; j < 4; ++j) { const int n = (lane >> 3) + 8 * j; const LAS float* s = scr + (8 * c) * 33 + n;
        u32x4 o; o.x = pk2(s[0 * 33], s[1 * 33]); o.y = pk2(s[2 * 33], s[3 * 33]); o.z = pk2(s[4 * 33], s[5 * 33]); o.w = pk2(s[6 * 33], s[7 * 33]);
        const int nn = n0 + n; const int row = (mode == 0) ? nn : ((nn >> 7) * 256 + (nn & 127) + (mode == 2 ? 128 : 0));
        *(u32x4*)(WT + (size_t)row * K + k0 + 8 * c) = o; }
    asm volatile("s_waitcnt lgkmcnt(0)" ::: "memory");
}
__device__ __forceinline__ void tr_job(const Ctx& F, int& base, const float* W, int K, int Nsrc, int c0, int ncols, int mode, bf16_t* WT, LAS float* scr, int gw = -1, int NGW = 0) {
    if (gw < 0) { gw = F.bid * 8 + F.wave; NGW = F.G * 8; }
    const int nnb = ncols / 32, items = (K / 64) * nnb;
    const int first = (gw - base % NGW + NGW) % NGW;
    for (int it = first; it < items; it += NGW) transpose_item(W, K, Nsrc, c0, WT, mode, scr, it / nnb, it % nnb, F.lane);
    base += items;
}

__device__ __forceinline__ void s5_precompute(const Ctx& F, int g) {
    const Params& P = *F.p;
    LAS float* AP = (LAS float*)F.lds;
    LAS float* BB = AP + 17 * 128;
    LAS float* CC = BB + 2048;
    LAS float* KD = CC + 2048;
    LAS float* FF = KD + 4096;
    const int tid = F.tid;
    if (tid < 64) {
        const int n = tid; const float lr = P.in[9][g * 64 + n], li = P.in[10][g * 64 + n], dt = expf(P.in[11][g]);
        const float mag = expf(lr * dt); float sn, cs; sincosf(li * dt, &sn, &cs);
        const float ar = mag * cs, ai = mag * sn, den = lr * lr + li * li, nr = ar - 1.0f, ni = ai;
        FF[2 * n] = (nr * lr + ni * li) / den; FF[2 * n + 1] = (ni * lr - nr * li) / den;
        float pr = 1.f, pi = 0.f;
        for (int d = 0; d <= 16; ++d) { AP[(d * 64 + n) * 2] = pr; AP[(d * 64 + n) * 2 + 1] = pi; const float tr = pr * ar - pi * ai, ti = pr * ai + pi * ar; pr = tr; pi = ti; }
        float* A16 = WSP(float, WS_SMALL + SM_A16) + g * 128;
        A16[n] = AP[(16 * 64 + n) * 2]; A16[64 + n] = AP[(16 * 64 + n) * 2 + 1];
    }
    __syncthreads();
    for (int idx = tid; idx < 1024; idx += 512) {
        const int n = idx >> 4, q = idx & 15; const float br = P.in[12][(g * 64 + n) * 16 + q], bi = P.in[13][(g * 64 + n) * 16 + q], fr_ = FF[2 * n], fi_ = FF[2 * n + 1];
        BB[idx * 2] = fr_ * br - fi_ * bi; BB[idx * 2 + 1] = fr_ * bi + fi_ * br;
        const int p = idx >> 6, nn = idx & 63;
        CC[idx * 2] = P.in[14][(g * 16 + p) * 64 + nn]; CC[idx * 2 + 1] = P.in[15][(g * 16 + p) * 64 + nn];
    }
    __syncthreads();
    for (int idx = tid; idx < 4096; idx += 512) {
        const int d = idx >> 8, p = (idx >> 4) & 15, q = idx & 15; float s = 0.f;
        for (int n = 0; n < 64; ++n) { const float cr = CC[(p * 64 + n) * 2], ci = CC[(p * 64 + n) * 2 + 1], ar = AP[(d * 64 + n) * 2], ai = AP[(d * 64 + n) * 2 + 1], br = BB[(n * 16 + q) * 2], bi = BB[(n * 16 + q) * 2 + 1];
            const float zr = cr * ar - ci * ai, zi = cr * ai + ci * ar; s += zr * br - zi * bi; }
        if (d == 0 && p == q) s += P.in[16][g * 16 + p];
        KD[idx] = s;
    }
    __syncthreads();
    bf16_t* KT = WSP(bf16_t, WS_BIG + B_S5KT) + (size_t)g * 256 * 384;
    for (int ch = tid; ch < 256 * 48; ch += 512) {
        const int n = ch / 48, k0 = (ch % 48) * 8, t = n >> 4, p = n & 15; float v[8];
#pragma unroll
        for (int j = 0; j < 8; ++j) { const int k = k0 + j;
            if (k < 256) { const int s = k >> 4, q = k & 15; v[j] = (s <= t) ? KD[((t - s) * 16 + p) * 16 + q] : 0.f; }
            else { const int kk = k - 256, nn = kk & 63; const float cr = CC[(p * 64 + nn) * 2], ci = CC[(p * 64 + nn) * 2 + 1], ar = AP[((t + 1) * 64 + nn) * 2], ai = AP[((t + 1) * 64 + nn) * 2 + 1];
                v[j] = (kk < 64) ? (cr * ar - ci * ai) : -(cr * ai + ci * ar); } }
        u32x4 o; o.x = pk2(v[0], v[1]); o.y = pk2(v[2], v[3]); o.z = pk2(v[4], v[5]); o.w = pk2(v[6], v[7]);
        *(u32x4*)(KT + (size_t)n * 384 + k0) = o;
    }
    bf16_t* WT = WSP(bf16_t, WS_BIG + B_S5WT) + (size_t)g * 128 * 256;
    for (int ch = tid; ch < 128 * 32; ch += 512) {
        const int np = ch / 32, k0 = (ch % 32) * 8, n = np & 63; float v[8];
#pragma unroll
        for (int j = 0; j < 8; ++j) { const int k = k0 + j, s = k >> 4, q = k & 15; const float ar = AP[((15 - s) * 64 + n) * 2], ai = AP[((15 - s) * 64 + n) * 2 + 1], br = BB[(n * 16 + q) * 2], bi = BB[(n * 16 + q) * 2 + 1];
            v[j] = (np < 64) ? (ar * br - ai * bi) : (ar * bi + ai * br); }
        u32x4 o; o.x = pk2(v[0], v[1]); o.y = pk2(v[2], v[3]); o.z = pk2(v[4], v[5]); o.w = pk2(v[6], v[7]);
        *(u32x4*)(WT + (size_t)np * 256 + k0) = o;
    }
    __syncthreads();
}

__device__ __forceinline__ void ada_gemv(const Ctx& F, const LAS float* sc, int layer, int gw, int NGW) {
    const Params& P = *F.p; float* MODP = WSP(float, WS_SMALL + SM_MODP);
    for (int task = gw; task < 192 * 8; task += NGW) {
        const int kp = task & 7, cb = task >> 3;
        const float* W = P.in[layer ? 27 : 2] + (size_t)(kp * 256) * 12288 + cb * 64 + F.lane;
        float acc = 0.f;
#pragma unroll 16
        for (int k = 0; k < 256; ++k) acc += sc[kp * 256 + k] * W[(size_t)k * 12288];
        MODP[(size_t)(kp * 2 + layer) * 12288 + cb * 64 + F.lane] = acc;
    }
}
__device__ __forceinline__ void ada_gemv_layer1_idle(const Ctx& F, int first_idle, int end_idle) {
    const Params& P = *F.p;
    LAS float* sc = (LAS float*)F.lds;
    for (int k = F.tid; k < DM; k += 512) sc[k] = siluf_(P.in[1][k]);
    __syncthreads();
    ada_gemv(F, sc, 1, (F.bid - first_idle) * 8 + F.wave, (end_idle - first_idle) * 8);
    __syncthreads();
    LAS float* scr = (LAS float*)F.lds + F.wave * (64 * 33);
    char* Wb = (char*)WSP(bf16_t, WS_W); int base = 0; const int gw = (F.bid - first_idle) * 8 + F.wave, NGW = (end_idle - first_idle) * 8;
    tr_job(F, base, P.in[23], 2048, 2048, 0, 2048, 0, (bf16_t*)(Wb + W_OUT0), scr, gw, NGW);
    tr_job(F, base, P.in[26], 5632, 2048, 0, 2048, 0, (bf16_t*)(Wb + W_DN0), scr, gw, NGW);
    tr_job(F, base, P.in[33], 2048, 6160, 0, 6144, 0, (bf16_t*)(Wb + W_IN1), scr, gw, NGW);
}
__device__ __forceinline__ void phase_prologue(const Ctx& F) {
    const Params& P = *F.p;
    if (F.bid < 64) s5_precompute(F, F.bid);
    LAS float* sc = (LAS float*)F.lds;
    for (int k = F.tid; k < DM; k += 512) sc[k] = siluf_(P.in[1][k]);
    __syncthreads();
    if (F.bid >= 64) ada_gemv(F, sc, 0, (F.bid - 64) * 8 + F.wave, (F.G - 64) * 8);
    __syncthreads();
    LAS float* scr = (LAS float*)F.lds + F.wave * (64 * 33);
    char* Wb = (char*)WSP(bf16_t, WS_W); int base = 0;
    tr_job(F, base, P.in[8], 2048, 4112, 0, 4096, 0, (bf16_t*)(Wb + W_IN0), scr);
    tr_job(F, base, P.in[17], 1024, 1024, 0, 1024, 0, (bf16_t*)(Wb + W_GLU), scr);
    tr_job(F, base, P.in[24], 2048, 5632, 0, 5632, 1, (bf16_t*)(Wb + W_GU0), scr);
    tr_job(F, base, P.in[25], 2048, 5632, 0, 5632, 2, (bf16_t*)(Wb + W_GU0), scr);
}
__device__ __forceinline__ void convert_layer1_in(const Ctx& F) {
    const Params& P = *F.p;
    LAS float* scr = (LAS float*)F.lds + F.wave * (64 * 33);
    char* Wb = (char*)WSP(bf16_t, WS_W); int base = 0;
    tr_job(F, base, P.in[33], 2048, 6160, 0, 6144, 0, (bf16_t*)(Wb + W_IN1), scr);
}
__device__ __forceinline__ void convert_layer1_rest_idle(const Ctx& F, int first_idle, int end_idle) {
    const Params& P = *F.p;
    LAS float* scr = (LAS float*)F.lds + F.wave * (64 * 33);
    char* Wb = (char*)WSP(bf16_t, WS_W); int base = 0; const int gw = (F.bid - first_idle) * 8 + F.wave, NGW = (end_idle - first_idle) * 8;
    tr_job(F, base, P.in[37], 2048, 2048, 0, 2048, 0, (bf16_t*)(Wb + W_OUT1), scr, gw, NGW);
    tr_job(F, base, P.in[38], 2048, 5632, 0, 5632, 1, (bf16_t*)(Wb + W_GU1), scr, gw, NGW);
    tr_job(F, base, P.in[39], 2048, 5632, 0, 5632, 2, (bf16_t*)(Wb + W_GU1), scr, gw, NGW);
    tr_job(F, base, P.in[40], 5632, 2048, 0, 2048, 0, (bf16_t*)(Wb + W_DN1), scr, gw, NGW);
}

__device__ __forceinline__ float treduce16(float (&t)[16], int lane) {
#pragma unroll
    for (int half = 8, off = 32; half >= 1; half >>= 1, off >>= 1) {
        const bool up = (lane & off) != 0;
#pragma unroll
        for (int i = 0; i < half; ++i) { const float a = t[i], b = t[i + half]; const float send = up ? a : b, keep = up ? b : a; t[i] = keep + __shfl_xor(send, off); }
    }
    float r = t[0]; r += __shfl_xor(r, 2); r += __shfl_xor(r, 1); return r;
}
struct RowCfg;
template <bool POST, bool PRE>
__device__ __forceinline__ void row_core(const Params& P, const RowCfg& c, LAS float* vA, LAS float* vB, LAS float* vP, const bf16_t* RAW, const float* SSQ, bf16_t* H, int row, int lane, f32x4 (&v)[8]);
struct RowCfg { int lpost, gt_off, wpost_in, lpre, wpre_in, sc_off, sh_off, thin_in, thin_nsrc, thin_c0; const float* xsrc; float* thin_out; };
template <bool POST, bool PRE>
__device__ __forceinline__ void row_core(const Params& P, const RowCfg& c, LAS float* vA, LAS float* vB, LAS float* vP, const bf16_t* RAW, const float* SSQ, bf16_t* H, int row, int lane, f32x4 (&v)[8]) {
    const f32x4* xs = (const f32x4*)(c.xsrc + (size_t)row * DM) + lane;
#pragma unroll
    for (int j = 0; j < 8; ++j) v[j] = xs[64 * j];
    if (POST) {
        const u32x2* rs = (const u32x2*)(RAW + (size_t)row * DM) + lane;
        float s = (lane < 32) ? SSQ[(size_t)row * 32 + lane] : 0.f; s = wave_sum(s);
        const float rstd = rsqrtf(s * (1.0f / DM) + EPS);
        f32x4* os = (f32x4*)(P.out + (size_t)row * DM) + lane;
#pragma unroll
        for (int j = 0; j < 8; ++j) { const u32x2 rb = rs[64 * j]; const f32x4 r = (f32x4){__uint_as_float(rb.x << 16), __uint_as_float(rb.x & 0xffff0000u), __uint_as_float(rb.y << 16), __uint_as_float(rb.y & 0xffff0000u)};
            const f32x4 pv = *(const LAS f32x4*)(vP + j * 256 + lane * 4); v[j] += r * rstd * pv; os[64 * j] = v[j]; }
    }
    if (PRE) {
        float s2 = 0.f;
#pragma unroll
        for (int j = 0; j < 8; ++j) s2 += (v[j][0] * v[j][0] + v[j][1] * v[j][1]) + (v[j][2] * v[j][2] + v[j][3] * v[j][3]);
        s2 = wave_sum(s2);
        const float rstd2 = rsqrtf(s2 * (1.0f / DM) + EPS);
        u32x2* hs = (u32x2*)(H + (size_t)row * DM) + lane;
#pragma unroll
        for (int j = 0; j < 8; ++j) { const f32x4 a = *(const LAS f32x4*)(vA + j * 256 + lane * 4), b = *(const LAS f32x4*)(vB + j * 256 + lane * 4);
            v[j] = v[j] * rstd2 * a + b; u32x2 w; w.x = cvt_pk_bf16(v[j][0], v[j][1]); w.y = cvt_pk_bf16(v[j][2], v[j][3]); hs[64 * j] = w; }
    }
}
template <bool POST, bool PRE, bool THIN>
__device__ __forceinline__ void row_phase(const Ctx& F, const RowCfg c) {
    const Params& P = *F.p;
    LAS float* vA = (LAS float*)F.lds; LAS float* vB = vA + 2048; LAS float* vP = vB + 2048; LAS float* tw = vP + 2048;
    const float* MODP = WSP(float, WS_SMALL + SM_MODP);
    const float* adab_post = P.in[c.lpost ? 28 : 3]; const float* adab_pre = P.in[c.lpre ? 28 : 3];
    for (int j = F.tid; j < DM; j += 512) {
        if (POST) { float g = adab_post[c.gt_off + j]; for (int pp = 0; pp < 8; ++pp) g += MODP[(size_t)(pp * 2 + c.lpost) * 12288 + c.gt_off + j]; vP[j] = g * P.in[c.wpost_in][j]; }
        if (PRE) { float s = adab_pre[c.sc_off + j], h = adab_pre[c.sh_off + j];
            for (int pp = 0; pp < 8; ++pp) { s += MODP[(size_t)(pp * 2 + c.lpre) * 12288 + c.sc_off + j]; h += MODP[(size_t)(pp * 2 + c.lpre) * 12288 + c.sh_off + j]; }
            vA[j] = P.in[c.wpre_in][j] * (1.0f + s); vB[j] = h; }
    }
    if (THIN) { const float* W = P.in[c.thin_in]; for (int e = F.tid; e < 16 * 2048; e += 512) { const int k = e >> 4, cc = e & 15; tw[cc * 2048 + k] = W[(size_t)k * c.thin_nsrc + c.thin_c0 + cc]; } }
    __syncthreads();
    const int gw = F.bid * 8 + F.wave, NGW = F.G * 8, lane = F.lane;
    const bf16_t* RAW = WSP(bf16_t, WS_RAW); const float* SSQ = WSP(float, WS_SMALL + SM_SSQ); bf16_t* H = WSP(bf16_t, WS_H);
    if (!THIN) {
        for (int row = gw; row < SEQ; row += NGW) { f32x4 v[8]; row_core<POST, PRE>(P, c, vA, vB, vP, RAW, SSQ, H, row, lane, v); }
    } else {
        for (int row = gw; row < SEQ; row += 2 * NGW) {
            f32x4 v0[8], v1[8];
            const int rowB = row + NGW; const bool hasB = rowB < SEQ;
            row_core<POST, PRE>(P, c, vA, vB, vP, RAW, SSQ, H, row, lane, v0);
            if (hasB) row_core<POST, PRE>(P, c, vA, vB, vP, RAW, SSQ, H, rowB, lane, v1);
            else {
#pragma unroll
                for (int j = 0; j < 8; ++j) v1[j] = (f32x4){0.f, 0.f, 0.f, 0.f}; }
            float t0[16], t1[16];
#pragma unroll
            for (int cc = 0; cc < 16; ++cc) { float a0 = 0.f, a1 = 0.f;
#pragma unroll
                for (int j = 0; j < 8; ++j) { const f32x4 w = *(const LAS f32x4*)(tw + cc * 2048 + j * 256 + lane * 4);
                    a0 += (v0[j][0] * w[0] + v0[j][1] * w[1]) + (v0[j][2] * w[2] + v0[j][3] * w[3]);
                    a1 += (v1[j][0] * w[0] + v1[j][1] * w[1]) + (v1[j][2] * w[2] + v1[j][3] * w[3]); }
                t0[cc] = a0; t1[cc] = a1; }
            const float r0 = treduce16(t0, lane), r1 = treduce16(t1, lane);
            if ((lane & 3) == 0) { c.thin_out[(size_t)row * 16 + ((lane >> 2) & 15)] = r0; if (hasB) c.thin_out[(size_t)rowB * 16 + ((lane >> 2) & 15)] = r1; }
        }
    }
}

__device__ __forceinline__ void s5_wu_phase(const Ctx& F) {
    const Params& P = *F.p;
    const bf16_t* UG = WSP(bf16_t, WS_BIG + B_UG); const bf16_t* WTb = WSP(bf16_t, WS_BIG + B_S5WT); float* WU = WSP(float, WS_BIG + B_S5WU);
    const int gw = F.bid * 8 + F.wave, NGW = F.G * 8, lane = F.lane, fr = lane & 15, fq = lane >> 4;
    for (int task = gw; task < 64 * 64; task += NGW) {
        const int g = task >> 6, c0 = (task & 63) * 16;
        bf16x8 a[8];
#pragma unroll
        for (int ks = 0; ks < 8; ++ks) a[ks] = *(const bf16x8*)(UG + ((size_t)g * SEQ + (size_t)(c0 + fr) * 16) * 16 + ks * 32 + fq * 8);
        const bf16_t* WT = WTb + (size_t)g * 128 * 256;
#pragma unroll 2
        for (int nt = 0; nt < 8; ++nt) {
            f32x4 acc = (f32x4){0.f, 0.f, 0.f, 0.f};
#pragma unroll
            for (int ks = 0; ks < 8; ++ks) { const bf16x8 b = *(const bf16x8*)(WT + (size_t)(nt * 16 + fr) * 256 + ks * 32 + fq * 8); acc = mfma16(b, a[ks], acc); }
            *(f32x4*)(WU + ((size_t)g * 1024 + c0 + fr) * 128 + nt * 16 + fq * 4) = acc;
        }
    }
}
__device__ __forceinline__ float gelu_tanh(float x) { const float z = 0.7978845608028654f * (x + 0.044715f * x * x * x); const float e = __expf(2.0f * z); const float th = 1.0f - 2.0f * __builtin_amdgcn_rcpf(e + 1.0f); return 0.5f * x * (1.0f + th); }
__device__ __forceinline__ void s5_group_phase(const Ctx& F, int g) {
    const Params& P = *F.p;
    const bf16_t* UG = WSP(bf16_t, WS_BIG + B_UG) + (size_t)g * SEQ * 16; const float* WU = WSP(float, WS_BIG + B_S5WU) + (size_t)g * 1024 * 128;
    bf16_t* XC = WSP(bf16_t, WS_BIG + B_S5XC) + (size_t)g * 1024 * 128; const bf16_t* KT = WSP(bf16_t, WS_BIG + B_S5KT) + (size_t)g * 256 * 384;
    bf16_t* YG = WSP(bf16_t, WS_BIG + B_YG);
    const int tid = F.tid, lane = F.lane, fr = lane & 15, fq = lane >> 4;
    {
        LAS float* wu = (LAS float*)F.lds;
        LAS bf16_t* xs = (LAS bf16_t*)(F.lds + 65536);
        const float* A16 = WSP(float, WS_SMALL + SM_A16) + g * 128; const float ar = A16[lane], ai = A16[64 + lane]; float cr = 0.f, ci = 0.f;
        for (int blk = 0; blk < 8; ++blk) {
            f32x4 t[8];
#pragma unroll
            for (int i = 0; i < 8; ++i) t[i] = *(const f32x4*)(WU + (size_t)blk * 16384 + (size_t)(i * 512 + tid) * 4);
#pragma unroll
            for (int i = 0; i < 8; ++i) *(LAS f32x4*)(wu + (i * 512 + tid) * 4) = t[i];
            __syncthreads();
            if (F.wave == 0) {
#pragma unroll 8
                for (int c = 0; c < 128; ++c) { const float wr_ = wu[c * 128 + lane], wi_ = wu[c * 128 + 64 + lane];
                    xs[c * 128 + lane] = (bf16_t)f2bf(cr); xs[c * 128 + 64 + lane] = (bf16_t)f2bf(ci);
                    const float nr = ar * cr - ai * ci + wr_, ni = ar * ci + ai * cr + wi_; cr = nr; ci = ni; }
            }
            __syncthreads();
#pragma unroll
            for (int i = 0; i < 4; ++i) *(u32x4*)(XC + (size_t)blk * 16384 + (size_t)(i * 512 + tid) * 8) = *(const LAS u32x4*)(xs + (i * 512 + tid) * 8);
        }
    }
    __threadfence(); __syncthreads();
    LAS bf16_t* As = (LAS bf16_t*)F.lds;
    bf16x8 bfr[2][12];
#pragma unroll
    for (int t2 = 0; t2 < 2; ++t2)
#pragma unroll
        for (int ks = 0; ks < 12; ++ks) bfr[t2][ks] = *(const bf16x8*)(KT + (size_t)((F.wave * 2 + t2) * 16 + fr) * 384 + ks * 32 + fq * 8);
    u32x4 pu, px; px = (u32x4){0u, 0u, 0u, 0u};
    pu = *(const u32x4*)(UG + (size_t)tid * 8); if (tid < 256) px = *(const u32x4*)(XC + (size_t)tid * 8);
    *(LAS u32x4*)(As + (tid >> 5) * 392 + (tid & 31) * 8) = pu; if (tid < 256) *(LAS u32x4*)(As + (tid >> 4) * 392 + 256 + (tid & 15) * 8) = px;
    __syncthreads();
    for (int mt = 0; mt < 64; ++mt) {
        const int c0 = mt * 16, buf = mt & 1;
        if (mt + 1 < 64) { pu = *(const u32x4*)(UG + (size_t)(c0 + 16) * 256 + (size_t)tid * 8); if (tid < 256) px = *(const u32x4*)(XC + (size_t)(c0 + 16) * 128 + (size_t)tid * 8); }
        bf16x8 a[12];
#pragma unroll
        for (int ks = 0; ks < 12; ++ks) a[ks] = *(const LAS bf16x8*)(As + buf * 6272 + fr * 392 + ks * 32 + fq * 8);
#pragma unroll
        for (int t2 = 0; t2 < 2; ++t2) {
            f32x4 acc = (f32x4){0.f, 0.f, 0.f, 0.f};
#pragma unroll
            for (int ks = 0; ks < 12; ++ks) acc = mfma16(bfr[t2][ks], a[ks], acc);
            const int t = F.wave * 2 + t2;
            u32x2 w; w.x = pk2(gelu_tanh(acc[0]), gelu_tanh(acc[1])); w.y = pk2(gelu_tanh(acc[2]), gelu_tanh(acc[3]));
            *(u32x2*)(YG + (size_t)((c0 + fr) * 16 + t) * 1024 + g * 16 + fq * 4) = w;
        }
        if (mt + 1 < 64) { *(LAS u32x4*)(As + (buf ^ 1) * 6272 + (tid >> 5) * 392 + (tid & 31) * 8) = pu; if (tid < 256) *(LAS u32x4*)(As + (buf ^ 1) * 6272 + (tid >> 4) * 392 + 256 + (tid & 15) * 8) = px; }
        __syncthreads();
    }
}

__device__ __forceinline__ void gdn_local_unit(const Ctx& F, int hv, int n) {
    const Params& P = *F.p;
    LAS unsigned char* lds = F.lds;
    LAS float* tmp = (LAS float*)lds;
    LAS float* Lf = (LAS float*)lds;
    LAS bf16_t* Tb = (LAS bf16_t*)(lds + 16384);
    LAS bf16_t* At = (LAS bf16_t*)(lds + 25600);
    LAS bf16_t* wT = (LAS bf16_t*)(lds + 34816);
    LAS bf16_t* uT = (LAS bf16_t*)(lds + 53248);
    LAS bf16_t* qn = (LAS bf16_t*)(lds + 71680);
    LAS bf16_t* kn = (LAS bf16_t*)(lds + 89088);
    LAS bf16_t* vbT = (LAS bf16_t*)(lds + 106496);
    LAS bf16_t* kbgT = (LAS bf16_t*)(lds + 124928);
    LAS bf16_t* kdT = (LAS bf16_t*)(lds + 143360);
    LAS float* gcs = (LAS float*)(lds + 161792);
    LAS float* bts = gcs + 64;
    const int tid = F.tid, lane = F.lane, w = F.wave, fr = lane & 15, fq = lane >> 4;
    const int hq = hv >> 1, t0 = n * 64, u = hv * 256 + n;
    const bf16_t* Y0 = WSP(bf16_t, WS_BIG + B_Y); const float* AB = WSP(float, WS_SMALL + SM_AB);
    if (tid < 64) {
        const float av = AB[(size_t)(t0 + tid) * 16 + hv], bv = AB[(size_t)(t0 + tid) * 16 + 8 + hv];
        const float xx = av + P.in[21][hv]; const float sp = (xx > 20.f) ? xx : log1pf(expf(xx));
        float gv = -expf(P.in[20][hv]) * sp;
#pragma unroll
        for (int o = 1; o < 64; o <<= 1) { const float t = __shfl_up(gv, o); if (lane >= o) gv += t; }
        gcs[tid] = gv; bts[tid] = sigmoidf_(bv);
        if (tid == 63) WSP(float, WS_SMALL + SM_GG)[u] = expf(gv);
    }
    __syncthreads();
    if (tid < 384) {
        const int which = tid >> 7, d = tid & 127;
        const int col = (which == 0) ? (1024 + hq * 128 + d) : (which == 1) ? (1536 + hq * 128 + d) : (2048 + hv * 128 + d);
        const int ch = (which == 0) ? (hq * 128 + d) : (which == 1) ? (512 + hq * 128 + d) : (1024 + hv * 128 + d);
        const float* cw = P.in[19]; const float w0 = cw[ch], w1 = cw[2048 + ch], w2 = cw[4096 + ch], w3 = cw[6144 + ch];
        const bf16_t* src = Y0 + col;
        unsigned short xin[67];
#pragma unroll
        for (int i = 0; i < 67; ++i) { const int tt = t0 - 3 + i; const unsigned short xv = src[(size_t)(tt < 0 ? 0 : tt) * 4096]; xin[i] = (tt >= 0) ? xv : (unsigned short)0; }
#pragma unroll
        for (int t = 0; t < 64; ++t) {
            float y = w0 * bf2f(xin[t]) + w1 * bf2f(xin[t + 1]) + w2 * bf2f(xin[t + 2]) + w3 * bf2f(xin[t + 3]); y = siluf_(y);
            if (which < 2) tmp[(which * 64 + t) * 129 + d] = y; else vbT[d * 72 + t] = (bf16_t)f2bf(y * bts[t]);
        }
    }
    __syncthreads();
    {
        const int which = w >> 2; const float gl = gcs[63];
        for (int rr = 0; rr < 16; ++rr) {
            const int t = (w & 3) * 16 + rr; const float a = tmp[(which * 64 + t) * 129 + lane], b = tmp[(which * 64 + t) * 129 + lane + 64];
            const float ss = wave_sum(a * a + b * b); float rinv = rsqrtf(ss + EPS);
            if (which == 0) { rinv *= 0.08838834764831845f; qn[t * 136 + lane] = (bf16_t)f2bf(a * rinv); qn[t * 136 + lane + 64] = (bf16_t)f2bf(b * rinv); }
            else { const float ka = a * rinv, kb = b * rinv, gt = gcs[t]; const float e1 = bts[t] * __expf(gt), e2 = __expf(gl - gt);
                kn[t * 136 + lane] = (bf16_t)f2bf(ka); kn[t * 136 + lane + 64] = (bf16_t)f2bf(kb);
                kbgT[lane * 72 + t] = (bf16_t)f2bf(ka * e1); kbgT[(lane + 64) * 72 + t] = (bf16_t)f2bf(kb * e1);
                kdT[lane * 72 + t] = (bf16_t)f2bf(ka * e2); kdT[(lane + 64) * 72 + t] = (bf16_t)f2bf(kb * e2); }
        }
    }
    __syncthreads();
    {
        const int which = w >> 2, mt = w & 3;
        for (int nt = 0; nt < 4; ++nt) {
            const f32x4 acc = tile_mm<false>(which ? qn : kn, 136, kn, 136, mt * 16, nt * 16, 4, fr, fq);
#pragma unroll
            for (int r = 0; r < 4; ++r) { const int i = mt * 16 + fq * 4 + r, j = nt * 16 + fr;
                const float dec = (i >= j) ? __expf(gcs[i] - gcs[j]) : 0.f;
                if (which == 0) Lf[i * 64 + j] = (i > j) ? bts[i] * acc[r] * dec : 0.f;
                else At[i * 72 + j] = (bf16_t)f2bf((i >= j) ? acc[r] * dec : 0.f); }
        }
    }
    __syncthreads();
    if (w == 0) {
        LAS float* Tf = (LAS float*)(lds + 34816);
        LAS float* Xs = (LAS float*)(lds + 51200);
        {
            const int b = lane >> 4, c = lane & 15; float t[16];
#pragma unroll
            for (int i = 0; i < 16; ++i) {
                float acc = (i == c) ? 1.f : 0.f;
#pragma unroll
                for (int j = 0; j < i; ++j) acc -= Lf[(16 * b + i) * 64 + 16 * b + j] * t[j];
                t[i] = acc;
            }
#pragma unroll
            for (int i = 0; i < 16; ++i) Tf[(16 * b + i) * 64 + 16 * b + c] = t[i];
        }
        const int ri = lane & 15, kk = lane >> 4;
#pragma unroll
        for (int i = 1; i < 4; ++i)
#pragma unroll
            for (int j = 0; j < i; ++j) {
                f32x4 acc = (f32x4){0.f, 0.f, 0.f, 0.f};
#pragma unroll
                for (int k = j; k < i; ++k)
#pragma unroll
                    for (int sq = 0; sq < 4; ++sq) acc = __builtin_amdgcn_mfma_f32_16x16x4f32(Lf[(16 * i + ri) * 64 + 16 * k + 4 * sq + kk], Tf[(16 * k + 4 * sq + kk) * 64 + 16 * j + ri], acc, 0, 0, 0);
#pragma unroll
                for (int r = 0; r < 4; ++r) Xs[(kk * 4 + r) * 16 + ri] = acc[r];
                f32x4 a2 = (f32x4){0.f, 0.f, 0.f, 0.f};
#pragma unroll
                for (int sq = 0; sq < 4; ++sq) a2 = __builtin_amdgcn_mfma_f32_16x16x4f32(Tf[(16 * i + ri) * 64 + 16 * i + 4 * sq + kk], Xs[(4 * sq + kk) * 16 + ri], a2, 0, 0, 0);
#pragma unroll
                for (int r = 0; r < 4; ++r) Tf[(16 * i + kk * 4 + r) * 64 + 16 * j + ri] = -a2[r];
            }
#pragma unroll 8
        for (int i = 0; i < 64; ++i) { const float v = ((i >> 4) >= (lane >> 4)) ? Tf[i * 64 + lane] : 0.f; Tb[i * 72 + lane] = (bf16_t)f2bf(v); }
    }
    __syncthreads();
    {
        const int which = w >> 2, mt = w & 3;
        for (int nt = 0; nt < 8; ++nt) {
            const f32x4 acc = tile_mm<false>(Tb, 72, which ? kbgT : vbT, 72, mt * 16, nt * 16, 2, fr, fq);
            u32x2 o; o.x = pk2(acc[0], acc[1]); o.y = pk2(acc[2], acc[3]);
            *(LAS u32x2*)((which ? wT : uT) + (nt * 16 + fr) * 72 + mt * 16 + fq * 4) = o;
        }
    }
    __syncthreads();
    {
        bf16_t* Pg = WSP(bf16_t, WS_H) + (size_t)u * 16384; bf16_t* RTg = WSP(bf16_t, WS_RAW + 64 * MiB) + (size_t)u * 16384;
        bf16_t* QEg = WSP(bf16_t, WS_BIG + B_QE) + (size_t)u * 8192; bf16_t* OUg = WSP(bf16_t, WS_BIG + B_OU) + (size_t)u * 8192;
        for (int tile = w; tile < 192; tile += 8) {
            if (tile < 64) { const int mt = tile >> 3, nt = tile & 7; const f32x4 acc = tile_mm<true>(kdT, 72, wT, 72, mt * 16, nt * 16, 2, fr, fq);
                u32x2 o; o.x = pk2(acc[0], acc[1]); o.y = pk2(acc[2], acc[3]);
                *(u32x2*)(Pg + (((mt * 4 + (nt >> 1)) * 64 + ((nt & 1) * 2 + (fq >> 1)) * 16 + fr) * 8 + (fq & 1) * 4)) = o; }
            else if (tile < 128) { const int tt = tile - 64, mt = tt >> 3, nt = tt & 7; const f32x4 acc = tile_mm<true>(uT, 72, kdT, 72, mt * 16, nt * 16, 2, fr, fq);
                u32x2 o; o.x = pk2(acc[0], acc[1]); o.y = pk2(acc[2], acc[3]); *(u32x2*)(RTg + ((mt * 8 + nt) * 64 + lane) * 4) = o; }
            else if (tile < 160) { const int tt = tile - 128, mt = tt >> 3, nt = tt & 7; const f32x4 acc = tile_mm<true>(At, 72, wT, 72, mt * 16, nt * 16, 2, fr, fq);
                const int i = mt * 16 + fr; const float eg = __expf(gcs[i]); float q[4];
#pragma unroll
                for (int r = 0; r < 4; ++r) q[r] = bf2f(qn[i * 136 + nt * 16 + fq * 4 + r]) * eg - acc[r];
                u32x2 o; o.x = pk2(q[0], q[1]); o.y = pk2(q[2], q[3]);
                *(u32x2*)(QEg + (((mt * 4 + (nt >> 1)) * 64 + ((nt & 1) * 2 + (fq >> 1)) * 16 + fr) * 8 + (fq & 1) * 4)) = o; }
            else { const int tt = tile - 160, mt = tt >> 3, nt = tt & 7; const f32x4 acc = tile_mm<true>(At, 72, uT, 72, mt * 16, nt * 16, 2, fr, fq);
                u32x2 o; o.x = pk2(acc[0], acc[1]); o.y = pk2(acc[2], acc[3]); *(u32x2*)(OUg + ((nt * 4 + mt) * 64 + lane) * 4) = o; }
        }
    }
    __syncthreads();
}

struct GS { bf16x8 pf[4], qf[4]; u32x2 rt, ou; float gl; };
__device__ __forceinline__ void gs_load(GS& x, const bf16_t* Pg, const bf16_t* RTg, const bf16_t* QEg, const bf16_t* OUg, const float* GG, int hv, int n, int w, int fr, int fq, int dv0) {
    const size_t u = (size_t)hv * 256 + n;
#pragma unroll
    for (int ks = 0; ks < 4; ++ks) x.pf[ks] = *(const bf16x8*)(Pg + u * 16384 + ((w * 4 + ks) * 64 + fq * 16 + fr) * 8);
    x.rt = *(const u32x2*)(RTg + u * 16384 + (((dv0 >> 4) * 8 + w) * 64 + fq * 16 + fr) * 4);
    x.gl = GG[u];
    if (w < 4) {
#pragma unroll
        for (int ks = 0; ks < 4; ++ks) x.qf[ks] = *(const bf16x8*)(QEg + u * 8192 + ((w * 4 + ks) * 64 + fq * 16 + fr) * 8);
        x.ou = *(const u32x2*)(OUg + u * 8192 + (((dv0 >> 4) * 4 + w) * 64 + fq * 16 + fr) * 4);
    }
}
__device__ __forceinline__ void gdn_scan_wg(const Ctx& F, int hv, int sl) {
    const Params& P = *F.p;
    LAS bf16_t* Sb = (LAS bf16_t*)F.lds;
    const int lane = F.lane, w = F.wave, fr = lane & 15, fq = lane >> 4, dv0 = sl * 16;
    const bf16_t* Pg = WSP(bf16_t, WS_H); const bf16_t* RTg = WSP(bf16_t, WS_RAW + 64 * MiB);
    const bf16_t* QEg = WSP(bf16_t, WS_BIG + B_QE); const bf16_t* OUg = WSP(bf16_t, WS_BIG + B_OU);
    const float* GG = WSP(float, WS_SMALL + SM_GG); bf16_t* O = WSP(bf16_t, WS_RAW);
    for (int e = F.tid; e < 2 * 16 * 136; e += 512) Sb[e] = 0;
    f32x4 s = (f32x4){0.f, 0.f, 0.f, 0.f};
    int* prog = WSP(int, WS_SMALL + SM_PROG) + hv * 64; const bool publish = (sl == 0);
    constexpr int RS = 4;
    GS ring[RS];
#pragma unroll
    for (int i = 0; i < RS - 1; ++i) gs_load(ring[i], Pg, RTg, QEg, OUg, GG, hv, i, w, fr, fq, dv0);
    asm volatile("s_waitcnt lgkmcnt(0)" ::: "memory"); __builtin_amdgcn_s_barrier(); asm volatile("" ::: "memory");
    for (int n0 = 0; n0 < 256; n0 += 4 * RS) {
#pragma unroll
        for (int j = 0; j < 4 * RS; ++j) {
            const int n = n0 + j;
            if (n < 256) {
            const int cur = n & 1;
            { const int nn = (n + RS - 1 < 256) ? n + RS - 1 : 255; gs_load(ring[(j + RS - 1) % RS], Pg, RTg, QEg, OUg, GG, hv, nn, w, fr, fq, dv0); }
            const GS& x = ring[j % RS];
            if (publish && F.tid == 0) __hip_atomic_store(prog, n, __ATOMIC_RELAXED, __HIP_MEMORY_SCOPE_AGENT);
            bf16x8 sf[4];
#pragma unroll
            for (int ks = 0; ks < 4; ++ks) sf[ks] = *(const LAS bf16x8*)(Sb + cur * 2176 + fr * 136 + ks * 32 + fq * 8);
            f32x4 pacc = (f32x4){0.f, 0.f, 0.f, 0.f};
#pragma unroll
            for (int ks = 0; ks < 4; ++ks) pacc = mfma16(x.pf[ks], sf[ks], pacc);
            if (w < 4) {
                f32x4 oacc = (f32x4){__uint_as_float(x.ou.x << 16), __uint_as_float(x.ou.x & 0xffff0000u), __uint_as_float(x.ou.y << 16), __uint_as_float(x.ou.y & 0xffff0000u)};
#pragma unroll
                for (int ks = 0; ks < 4; ++ks) oacc = mfma16(sf[ks], x.qf[ks], oacc);
                { u32x2 ob; ob.x = pk2(oacc[0], oacc[1]); ob.y = pk2(oacc[2], oacc[3]); *(u32x2*)(O + ((size_t)(hv * 8 + (dv0 >> 4)) * SEQ + (n * 64 + w * 16 + fr)) * 16 + fq * 4) = ob; }
            }
            const f32x4 rv = (f32x4){__uint_as_float(x.rt.x << 16), __uint_as_float(x.rt.x & 0xffff0000u), __uint_as_float(x.rt.y << 16), __uint_as_float(x.rt.y & 0xffff0000u)};
            s = s * x.gl + rv - pacc;
            u32x2 o; o.x = pk2(s[0], s[1]); o.y = pk2(s[2], s[3]);
            *(LAS u32x2*)(Sb + (cur ^ 1) * 2176 + fr * 136 + w * 16 + fq * 4) = o;
            asm volatile("s_waitcnt lgkmcnt(0)" ::: "memory"); __builtin_amdgcn_s_barrier(); asm volatile("" ::: "memory");
            }
        }
    }
    asm volatile("s_waitcnt vmcnt(0)" ::: "memory");
}
__device__ __forceinline__ void gdn_warm_wg(const Ctx& F, int hv, int wi) {
    const Params& P = *F.p;
    const char* Pg = (const char*)WSP(bf16_t, WS_H); const char* RTg = (const char*)WSP(bf16_t, WS_RAW + 64 * MiB);
    const char* QEg = (const char*)WSP(bf16_t, WS_BIG + B_QE); const char* OUg = (const char*)WSP(bf16_t, WS_BIG + B_OU);
    int* prog = WSP(int, WS_SMALL + SM_PROG) + hv * 64;
    unsigned sum = 0;
    for (int n = F.wave; n < 256; n += 8) {
        int spins = 0;
        while (true) { const int p = __hip_atomic_load(prog, __ATOMIC_RELAXED, __HIP_MEMORY_SCOPE_AGENT); if (p + 12 >= n || ++spins > 4000) break; __builtin_amdgcn_s_sleep(16); }
        const size_t u = (size_t)hv * 256 + n;
#pragma unroll
        for (int i = 0; i < 3; ++i) { const int li = wi * 192 + i * 64 + F.lane;
            const char* a = (li < 256) ? (Pg + u * 32768 + (size_t)li * 128) : (li < 512) ? (RTg + u * 32768 + (size_t)(li - 256) * 128) : (li < 640) ? (QEg + u * 16384 + (size_t)(li - 512) * 128) : (OUg + u * 16384 + (size_t)(li - 640) * 128);
            sum += *(const volatile unsigned*)a; }
    }
    if (sum == 0x9e3779b9u) prog[32] = (int)sum;
}
__device__ __forceinline__ void gdn_finalize(const Ctx& F) {
    const Params& P = *F.p;
    const bf16_t* O = WSP(bf16_t, WS_RAW); const bf16_t* Y0 = WSP(bf16_t, WS_BIG + B_Y); bf16_t* CAT = WSP(bf16_t, WS_CAT);
    const int gw = F.bid * 8 + F.wave, NGW = F.G * 8, lane = F.lane, d0 = (lane & 7) * 16;
    float nw[16];
#pragma unroll
    for (int i = 0; i < 16; ++i) nw[i] = P.in[22][d0 + i];
    for (int row = gw; row < SEQ; row += NGW) {
        float o[16]; const u32x4* op = (const u32x4*)(O + ((size_t)lane * SEQ + row) * 16);
        float ss = 0.f;
        { const u32x4 a = op[0], b = op[1]; const unsigned ww[8] = {a.x, a.y, a.z, a.w, b.x, b.y, b.z, b.w};
#pragma unroll
          for (int i = 0; i < 8; ++i) { o[2 * i] = __uint_as_float(ww[i] << 16); o[2 * i + 1] = __uint_as_float(ww[i] & 0xffff0000u); ss += o[2 * i] * o[2 * i] + o[2 * i + 1] * o[2 * i + 1]; } }
        ss += __shfl_xor(ss, 1); ss += __shfl_xor(ss, 2); ss += __shfl_xor(ss, 4);
        const float rstd = rsqrtf(ss * (1.0f / 128.0f) + EPS);
        const u32x4* zp = (const u32x4*)(Y0 + (size_t)row * 4096 + 3072 + lane * 16); unsigned zz[8];
        { const u32x4 a = zp[0], b = zp[1]; zz[0] = a.x; zz[1] = a.y; zz[2] = a.z; zz[3] = a.w; zz[4] = b.x; zz[5] = b.y; zz[6] = b.z; zz[7] = b.w; }
        unsigned ov[8];
#pragma unroll
        for (int i = 0; i < 8; ++i) { const float z0 = __uint_as_float(zz[i] << 16), z1 = __uint_as_float(zz[i] & 0xffff0000u);
            ov[i] = pk2(o[2 * i] * rstd * nw[2 * i] * siluf_(z0), o[2 * i + 1] * rstd * nw[2 * i + 1] * siluf_(z1)); }
        u32x4* cp = (u32x4*)(CAT + (size_t)row * 2048 + 1024 + lane * 16);
        cp[0] = (u32x4){ov[0], ov[1], ov[2], ov[3]}; cp[1] = (u32x4){ov[4], ov[5], ov[6], ov[7]};
    }
}

__device__ __forceinline__ void gla_local_unit(const Ctx& F, int h, int n) {
    const Params& P = *F.p;
    LAS float* bc = (LAS float*)F.lds;
    LAS bf16_t* qt = (LAS bf16_t*)(F.lds + 65536);
    LAS bf16_t* kt = (LAS bf16_t*)(F.lds + 99328);
    LAS float* gl = (LAS float*)(F.lds + 133120);
    const int tid = F.tid, lane = F.lane, w = F.wave, fr = lane & 15, fq = lane >> 4, t0 = n * 64, u = h * 256 + n;
    const bf16_t* Y1 = WSP(bf16_t, WS_BIG + B_Y); const float* GLOW = WSP(float, WS_SMALL + SM_GLOW);
    bf16_t* QT = WSP(bf16_t, WS_H) + (size_t)u * 16384; bf16_t* KDT = WSP(bf16_t, WS_H + 32 * MiB) + (size_t)u * 16384;
    bf16_t* ATT = WSP(bf16_t, WS_BIG + B_ATT) + (size_t)u * 4096; bf16_t* VT = WSP(bf16_t, WS_BIG + B_VT) + (size_t)u * 32768;
    float* GLAST = WSP(float, WS_SMALL + SM_GLAST);
    for (int e = tid; e < 1024; e += 512) gl[e] = GLOW[(size_t)t0 * 16 + e];
    __syncthreads();
    if (tid < 256) {
        const int dk = tid, col = h * 256 + dk; float w2[16];
#pragma unroll
        for (int j = 0; j < 16; ++j) w2[j] = P.in[34][j * 1024 + col];
        const float gb = P.in[35][col]; float run = 0.f;
        for (int t = 0; t < 64; ++t) { float x = gb;
#pragma unroll
            for (int j = 0; j < 16; ++j) x += gl[t * 16 + j] * w2[j];
            const float ls = fminf(x, 0.f) - __logf(1.0f + __expf(-fabsf(x)));
            run += ls * 0.0625f; bc[t * 256 + dk] = run; }
    } else {
        for (int rep = 0; rep < 2; ++rep) { const int dv = (tid - 256) + rep * 256; const bf16_t* src = Y1 + (size_t)t0 * 6144 + 2048 + h * 512 + dv;
            unsigned short x[64];
#pragma unroll
            for (int j = 0; j < 64; ++j) x[j] = src[(size_t)j * 6144];
#pragma unroll
            for (int c0 = 0; c0 < 64; c0 += 8) {
                u32x4 o; o.x = x[c0] | ((unsigned)x[c0 + 1] << 16); o.y = x[c0 + 2] | ((unsigned)x[c0 + 3] << 16); o.z = x[c0 + 4] | ((unsigned)x[c0 + 5] << 16); o.w = x[c0 + 6] | ((unsigned)x[c0 + 7] << 16);
                *(u32x4*)(VT + ((((dv >> 4) * 2 + (c0 >> 5)) * 64 + ((c0 >> 3) & 3) * 16 + (dv & 15)) * 8)) = o; } }
    }
    __syncthreads();
    for (int item = tid; item < 2048; item += 512) {
        const int dk = item & 255, tb = item >> 8; const float bl = bc[63 * 256 + dk]; float kd[8]; unsigned short qr[8], kr[8];
#pragma unroll
        for (int j = 0; j < 8; ++j) { const int t = tb * 8 + j; qr[j] = Y1[(size_t)(t0 + t) * 6144 + h * 256 + dk]; kr[j] = Y1[(size_t)(t0 + t) * 6144 + 1024 + h * 256 + dk]; }
#pragma unroll
        for (int j = 0; j < 8; ++j) { const int t = tb * 8 + j; const float b = bc[t * 256 + dk];
            const float q = bf2f(qr[j]) * 0.0625f, k = bf2f(kr[j]);
            qt[t * 264 + dk] = (bf16_t)f2bf(q * __expf(b));
            kt[t * 264 + dk] = (bf16_t)f2bf(k * __expf(-b)); kd[j] = k * __expf(bl - b); }
        u32x4 o; o.x = pk2(kd[0], kd[1]); o.y = pk2(kd[2], kd[3]); o.z = pk2(kd[4], kd[5]); o.w = pk2(kd[6], kd[7]);
        *(u32x4*)(KDT + ((((dk >> 4) * 2 + (tb >> 2)) * 64 + (tb & 3) * 16 + (dk & 15)) * 8)) = o;
        if (tb == 7) GLAST[(size_t)n * 1024 + h * 256 + dk] = __expf(bl);
    }
    __syncthreads();
    for (int t2 = 0; t2 < 2; ++t2) { const int tile = w * 2 + t2, mt = tile >> 2, nt = tile & 3;
        const f32x4 acc = tile_mm<true>(qt, 264, kt, 264, mt * 16, nt * 16, 8, fr, fq);
        const int i = mt * 16 + fr; float a[4];
#pragma unroll
        for (int r = 0; r < 4; ++r) { const int j = nt * 16 + fq * 4 + r; a[r] = (j <= i) ? acc[r] : 0.f; }
        u32x2 o; o.x = pk2(a[0], a[1]); o.y = pk2(a[2], a[3]); *(u32x2*)(ATT + (((mt * 2 + (nt >> 1)) * 64 + ((nt & 1) * 2 + (fq >> 1)) * 16 + fr) * 8 + (fq & 1) * 4)) = o; }
    for (int piece = tid; piece < 2048; piece += 512) { const int w_ = piece >> 8, mt = (piece >> 6) & 3, ln = piece & 63, fr_ = ln & 15, fq_ = ln >> 4;
        const LAS bf16_t* qp = qt + (mt * 16 + fr_) * 264 + w_ * 32 + fq_ * 4; const u32x2 lo = *(const LAS u32x2*)qp, hi = *(const LAS u32x2*)(qp + 16);
        *(u32x4*)(QT + (size_t)piece * 8) = (u32x4){lo.x, lo.y, hi.x, hi.y}; }
    __syncthreads();
}
struct LS { bf16x8 qf[4], kf[2][2], vf[2], af[2]; f32x4 g0, g1; };
__device__ __forceinline__ void ls_load(LS& x, const bf16_t* QT, const bf16_t* KDTb, const bf16_t* ATTb, const bf16_t* VTb, const float* GLAST, int h, int n, int w, int fr, int fq, int dv0, int dk0) {
    const size_t u = (size_t)h * 256 + n; const int lane = fq * 16 + fr;
#pragma unroll
    for (int mt = 0; mt < 4; ++mt) x.qf[mt] = *(const bf16x8*)(QT + u * 16384 + ((w * 4 + mt) * 64 + lane) * 8);
#pragma unroll
    for (int tl = 0; tl < 2; ++tl)
#pragma unroll
        for (int ks = 0; ks < 2; ++ks) x.kf[tl][ks] = *(const bf16x8*)(KDTb + u * 16384 + (((2 * w + tl) * 2 + ks) * 64 + lane) * 8);
#pragma unroll
    for (int ks = 0; ks < 2; ++ks) x.vf[ks] = *(const bf16x8*)(VTb + u * 32768 + (((dv0 >> 4) * 2 + ks) * 64 + lane) * 8);
    x.g0 = *(const f32x4*)(GLAST + (size_t)n * 1024 + h * 256 + dk0 + fq * 4); x.g1 = *(const f32x4*)(GLAST + (size_t)n * 1024 + h * 256 + dk0 + 16 + fq * 4);
    if (w < 4) {
#pragma unroll
        for (int ks = 0; ks < 2; ++ks) x.af[ks] = *(const bf16x8*)(ATTb + u * 4096 + ((w * 2 + ks) * 64 + lane) * 8);
    }
}
__device__ __forceinline__ void gla_scan_wg(const Ctx& F, int h, int sl) {
    const Params& P = *F.p;
    LAS float* OP = (LAS float*)F.lds;
    const int tid = F.tid, lane = F.lane, w = F.wave, fr = lane & 15, fq = lane >> 4, dv0 = sl * 16, dk0 = w * 32;
    const bf16_t* QT = WSP(bf16_t, WS_H); const bf16_t* KDTb = WSP(bf16_t, WS_H + 32 * MiB);
    const bf16_t* ATTb = WSP(bf16_t, WS_BIG + B_ATT); const bf16_t* VTb = WSP(bf16_t, WS_BIG + B_VT);
    const float* GLAST = WSP(float, WS_SMALL + SM_GLAST); bf16_t* O = WSP(bf16_t, WS_RAW);
    f32x4 s0 = (f32x4){0.f, 0.f, 0.f, 0.f}, s1 = s0;
    int* prog = WSP(int, WS_SMALL + SM_PROG) + (8 + (F.bid & 7)) * 64; const bool publish = (sl < 2);
    LS ring[3];
    ls_load(ring[0], QT, KDTb, ATTb, VTb, GLAST, h, 0, w, fr, fq, dv0, dk0);
    ls_load(ring[1], QT, KDTb, ATTb, VTb, GLAST, h, 1, w, fr, fq, dv0, dk0);
    for (int n0 = 0; n0 < 256; n0 += 12) {
#pragma unroll
        for (int j = 0; j < 12; ++j) {
            const int n = n0 + j;
            if (n < 256) {
                const int t0 = n * 64, buf = n & 1;
                { const int nn = (n + 2 < 256) ? n + 2 : 255; ls_load(ring[(j + 2) % 3], QT, KDTb, ATTb, VTb, GLAST, h, nn, w, fr, fq, dv0, dk0); }
                const LS& x = ring[j % 3];
                if (publish && tid == 0) __hip_atomic_store(prog, n, __ATOMIC_RELAXED, __HIP_MEMORY_SCOPE_AGENT);
                u32x4 sp; sp.x = pk2(s0[0], s0[1]); sp.y = pk2(s0[2], s0[3]); sp.z = pk2(s1[0], s1[1]); sp.w = pk2(s1[2], s1[3]);
                const bf16x8 sf = __builtin_bit_cast(bf16x8, sp);
                f32x4 op[4];
#pragma unroll
                for (int mt = 0; mt < 4; ++mt) op[mt] = mfma16(sf, x.qf[mt], (f32x4){0.f, 0.f, 0.f, 0.f});
                if (w < 4) {
                    f32x4 oi = (f32x4){0.f, 0.f, 0.f, 0.f};
#pragma unroll
                    for (int ks = 0; ks < 2; ++ks) oi = mfma16(x.vf[ks], x.af[ks], oi);
#pragma unroll
                    for (int mt = 0; mt < 4; ++mt) if (mt == w) op[mt] += oi;
                }
#pragma unroll
                for (int mt = 0; mt < 4; ++mt) *(LAS f32x4*)(OP + ((buf * 8 + w) * 64 + mt * 16 + fr) * 16 + fq * 4) = op[mt];
                f32x4 u0 = (f32x4){0.f, 0.f, 0.f, 0.f}, u1 = u0;
#pragma unroll
                for (int ks = 0; ks < 2; ++ks) { u0 = mfma16(x.kf[0][ks], x.vf[ks], u0); u1 = mfma16(x.kf[1][ks], x.vf[ks], u1); }
                s0 = s0 * x.g0 + u0; s1 = s1 * x.g1 + u1;
                asm volatile("s_waitcnt lgkmcnt(0)" ::: "memory"); __builtin_amdgcn_s_barrier(); asm volatile("" ::: "memory");
                { const int e = tid * 2; float a = 0.f, b = 0.f;
#pragma unroll
                    for (int ww = 0; ww < 8; ++ww) { const f32x2 xx = *(const LAS f32x2*)(OP + (buf * 8 + ww) * 1024 + e); a += xx[0]; b += xx[1]; }
                    *(unsigned*)(O + ((size_t)(h * 32 + (dv0 >> 4)) * SEQ + t0) * 16 + e) = pk2(a, b); }
            }
        }
    }
    asm volatile("s_waitcnt vmcnt(0)" ::: "memory");
}
__device__ __forceinline__ void gla_warm_wg(const Ctx& F, int xcd, int wi) {
    const Params& P = *F.p;
    const int h = xcd & 3;
    const char* QT = (const char*)WSP(bf16_t, WS_H); const char* KDTb = (const char*)WSP(bf16_t, WS_H + 32 * MiB);
    const char* ATTb = (const char*)WSP(bf16_t, WS_BIG + B_ATT); const char* VTb = (const char*)WSP(bf16_t, WS_BIG + B_VT);
    int* prog = WSP(int, WS_SMALL + SM_PROG) + (8 + xcd) * 64;
    unsigned sum = 0;
    for (int n = F.wave; n < 256; n += 8) {
        int spins = 0;
        while (true) { const int p = __hip_atomic_load(prog, __ATOMIC_RELAXED, __HIP_MEMORY_SCOPE_AGENT); if (p + 12 >= n || ++spins > 4000) break; __builtin_amdgcn_s_sleep(16); }
        const size_t u = (size_t)h * 256 + n;
#pragma unroll
        for (int i = 0; i < 5; ++i) { const int li = wi * 272 + i * 64 + F.lane;
            if (i * 64 + F.lane < 272) {
                const char* a = (li < 256) ? (QT + u * 32768 + (size_t)li * 128) : (li < 512) ? (KDTb + u * 32768 + (size_t)(li - 256) * 128) : (li < 576) ? (ATTb + u * 8192 + (size_t)(li - 512) * 128) : (VTb + u * 65536 + (size_t)(li - 576) * 128);
                sum += *(const volatile unsigned*)a; } }
    }
    if (sum == 0x9e3779b9u) prog[32] = (int)sum;
}
__device__ __forceinline__ void gla_finalize(const Ctx& F) {
    const Params& P = *F.p;
    const bf16_t* O = WSP(bf16_t, WS_RAW); const bf16_t* Y1 = WSP(bf16_t, WS_BIG + B_Y); bf16_t* CAT = WSP(bf16_t, WS_CAT);
    const int gw = F.bid * 8 + F.wave, NGW = F.G * 8, lane = F.lane, d0 = (lane & 15) * 32;
    for (int row = gw; row < SEQ; row += NGW) {
        f32x4 o[8]; const u32x4* op0 = (const u32x4*)(O + ((size_t)(lane * 2) * SEQ + row) * 16); const u32x4* op1 = (const u32x4*)(O + ((size_t)(lane * 2 + 1) * SEQ + row) * 16); float ss = 0.f;
        const u32x4 ob[4] = {op0[0], op0[1], op1[0], op1[1]};
#pragma unroll
        for (int i = 0; i < 8; ++i) { const u32x4 q4 = ob[i >> 1]; const unsigned w0 = (i & 1) ? q4.z : q4.x, w1 = (i & 1) ? q4.w : q4.y;
            o[i] = (f32x4){__uint_as_float(w0 << 16), __uint_as_float(w0 & 0xffff0000u), __uint_as_float(w1 << 16), __uint_as_float(w1 & 0xffff0000u)}; ss += (o[i][0] * o[i][0] + o[i][1] * o[i][1]) + (o[i][2] * o[i][2] + o[i][3] * o[i][3]); }
        ss += __shfl_xor(ss, 1); ss += __shfl_xor(ss, 2); ss += __shfl_xor(ss, 4); ss += __shfl_xor(ss, 8);
        const float rstd = rsqrtf(ss * (1.0f / 512.0f) + EPS);
        const u32x4* rp = (const u32x4*)(Y1 + (size_t)row * 6144 + 4096 + lane * 32); u32x4* cp = (u32x4*)(CAT + (size_t)row * 2048 + lane * 32);
#pragma unroll
        for (int i = 0; i < 4; ++i) { const u32x4 rv = rp[i]; const unsigned rr[4] = {rv.x, rv.y, rv.z, rv.w}; unsigned ov[4];
#pragma unroll
            for (int j = 0; j < 4; ++j) { const int e = i * 8 + j * 2; const float r0 = __uint_as_float(rr[j] << 16), r1 = __uint_as_float(rr[j] & 0xffff0000u);
                const float x0 = o[e >> 2][e & 3], x1 = o[(e + 1) >> 2][(e + 1) & 3];
                ov[j] = pk2(x0 * rstd * P.in[36][d0 + e] * siluf_(r0), x1 * rstd * P.in[36][d0 + e + 1] * siluf_(r1)); }
            cp[i] = (u32x4){ov[0], ov[1], ov[2], ov[3]}; }
    }
}

#define XB_TMO      128
#define XB_XCNT(j)  (256  + 64 * (j))
#define XB_XSUB(j)  (1280 + 64 * (j))
#define XB_XGEN(j)  (2304 + 64 * (j))
#define XB_TOP      3328
#define XB_TOPGEN   3392
#define XCD_BAR_WORDS 3456
#define XB_SPIN_CAP (1u << 18)
__device__ __forceinline__ unsigned xb_ld(unsigned* p)              { return __hip_atomic_load(p, __ATOMIC_RELAXED, __HIP_MEMORY_SCOPE_AGENT); }
__device__ __forceinline__ unsigned xb_add(unsigned* p, unsigned v) { return __hip_atomic_fetch_add(p, v, __ATOMIC_RELAXED, __HIP_MEMORY_SCOPE_AGENT); }
__device__ __forceinline__ unsigned xb_xcc_id() { return (unsigned)__builtin_amdgcn_s_getreg((3 << 11) | 20) & 0xFu; }
#define XB_SPIN(cond, bar) do { unsigned _sp = 0; while (cond) { __builtin_amdgcn_s_sleep(1); \
    if ((++_sp & 255u) == 0u) { if (xb_ld(&(bar)[XB_TMO])) break; if (_sp > XB_SPIN_CAP) { atomicAdd(&(bar)[XB_TMO], 1u); break; } } } } while (0)
struct XcdBarrier { unsigned* bar; unsigned x; volatile LAS unsigned* st; };
__device__ __forceinline__ XcdBarrier xcd_barrier_post(unsigned* bar, volatile LAS unsigned* st) {
    XcdBarrier b; b.bar = bar; b.x = xb_xcc_id(); b.st = st;
    if (threadIdx.x == 0) (void)xb_add(&bar[XB_XCNT(b.x)], 1u);
    return b;
}
__device__ __forceinline__ void xcd_barrier_complete(unsigned* bar, unsigned x, unsigned& nloc, unsigned& nx) {
    const unsigned G = gridDim.x * gridDim.y * gridDim.z;
    unsigned sum, cnt, mine, sp = 0u;
    for (;;) {
        sum = 0u; cnt = 0u; mine = 0u;
#pragma unroll
        for (unsigned j = 0; j < 16; ++j) { const unsigned c = xb_ld(&bar[XB_XCNT(j)]); sum += c; cnt += (c > 0u) ? 1u : 0u; mine = (j == x) ? c : mine; }
        if (sum == G) break;
        __builtin_amdgcn_s_sleep(1);
        if ((++sp & 255u) == 0u) { if (xb_ld(&bar[XB_TMO])) break; if (sp > XB_SPIN_CAP) { atomicAdd(&bar[XB_TMO], 1u); break; } }
    }
    nloc = mine > 0u ? mine : 1u; nx = cnt > 0u ? cnt : 1u;
}
__device__ __forceinline__ void xcd_barrier(const XcdBarrier& b) {
    asm volatile("s_waitcnt vmcnt(0)" ::: "memory");
    __syncthreads();
    if (threadIdx.x == 0) {
        unsigned* bar = b.bar;
        __builtin_amdgcn_s_waitcnt(0);
        unsigned nloc = b.st[0], nx = b.st[1];
        if (nloc == 0u) { xcd_barrier_complete(bar, b.x, nloc, nx); b.st[0] = nloc; b.st[1] = nx; }
        const unsigned old = xb_add(&bar[XB_XSUB(b.x)], 1u);
        const unsigned gen = old / nloc;
        if (old + 1u == (gen + 1u) * nloc) {
            __builtin_amdgcn_fence(__ATOMIC_RELEASE, "agent");
            asm volatile("s_waitcnt vmcnt(0)" ::: "memory");
            const unsigned og = xb_add(&bar[XB_TOP], 1u);
            const unsigned tg = og / nx;
            if (og + 1u == (tg + 1u) * nx) xb_add(&bar[XB_TOPGEN], 1u);
            else XB_SPIN(xb_ld(&bar[XB_TOPGEN]) == tg, bar);
            __builtin_amdgcn_fence(__ATOMIC_ACQUIRE, "agent");
            xb_add(&bar[XB_XGEN(b.x)], 1u);
            asm volatile("s_waitcnt vmcnt(0)" ::: "memory");
        } else {
            XB_SPIN(xb_ld(&bar[XB_XGEN(b.x)]) == gen, bar);
            __builtin_amdgcn_fence(__ATOMIC_ACQUIRE, "agent");
            asm volatile("s_waitcnt vmcnt(0)" ::: "memory");
        }
    }
    __syncthreads();
}

__global__ void __launch_bounds__(512, 2) fwd_megakernel(Params prm) {
    extern __shared__ __attribute__((aligned(16))) unsigned char lds_raw[];
    Ctx F; F.lds = (LAS unsigned char*)lds_raw; F.tid = threadIdx.x; F.lane = F.tid & 63; F.wave = __builtin_amdgcn_readfirstlane(F.tid >> 6); F.G = gridDim.x; F.bid = blockIdx.x; F.p = &prm;
    const Params& P = prm;
    const int lo = P.ph_lo, hi = P.ph_hi;
    volatile LAS unsigned* xst = (volatile LAS unsigned*)(F.lds + (LDS_BYTES - 16));
    XcdBarrier xb; xb.bar = WSP(unsigned, WS_SMALL + SM_XBAR); xb.x = 0; xb.st = xst;
    if (hi - lo > 1) { if (F.tid < 4) xst[F.tid] = 0u; __syncthreads(); xb = xcd_barrier_post(WSP(unsigned, WS_SMALL + SM_XBAR), xst); }
    if (hi > 1000) cg::this_grid().sync();
    bf16_t* Wb = WSP(bf16_t, WS_W);
#define WPTR(off) ((const bf16_t*)((const char*)Wb + (off)))
#define PHASE(k) if (lo <= (k) && (k) < hi)
#define SEAM(k) if (lo <= (k) && (k) + 1 < hi) { xcd_barrier(xb); }
    PHASE(0) { phase_prologue(F); } SEAM(0)
    PHASE(1) { RowCfg c{0, 0, 0, 0, 4, 2048, 0, 8, 4112, 4096, P.in[0], WSP(float, WS_SMALL + SM_AB)}; row_phase<false, true, true>(F, c); } SEAM(1)
    PHASE(2) { pg8::Gemm g{WSP(bf16_t, WS_H), WPTR(W_IN0), SEQ, 4096, 2048}; pg8::StaticOrder S; S.init(SEQ, 4096, F.G, F.bid); pg8::EpiIn0 E{WSP(bf16_t, WS_BIG + B_Y), 4096, WSP(bf16_t, WS_BIG + B_UG)}; pg8::gemm_phase(F.lds, g, S, E); } SEAM(2)
    PHASE(3) { if (F.bid == 0 && F.tid < 8) WSP(int, WS_SMALL + SM_PROG)[F.tid * 64] = 0; for (int un = F.bid; un < 2048; un += F.G) gdn_local_unit(F, un & 7, un >> 3); s5_wu_phase(F); } SEAM(3)
    PHASE(4) { if (F.bid < 64) { if (P.mode4 != 2) gdn_scan_wg(F, F.bid & 7, F.bid >> 3); } else if (F.bid < 128) { if (P.mode4 != 1) s5_group_phase(F, F.bid - 64); } else if (F.bid < 224) { if (P.mode4 != 2) ada_gemv_layer1_idle(F, 128, 224); } else gdn_warm_wg(F, F.bid & 7, (F.bid - 224) >> 3); } SEAM(4)
    PHASE(5) { pg8::Gemm g{WSP(bf16_t, WS_BIG + B_YG), WPTR(W_GLU), SEQ, 1024, 1024}; pg8::StaticOrder S; S.init(SEQ, 1024, F.G, F.bid);
               pg8::EpiGlu E{WSP(bf16_t, WS_CAT), 2048, WSP(bf16_t, WS_BIG + B_YG), 1024, P.in[18]}; pg8::gemm_phase(F.lds, g, S, E); gdn_finalize(F); } SEAM(5)
    PHASE(6) { pg8::Gemm g{WSP(bf16_t, WS_CAT), WPTR(W_OUT0), SEQ, 2048, 2048}; pg8::StaticOrder S; S.init(SEQ, 2048, F.G, F.bid); pg8::EpiRaw E{WSP(bf16_t, WS_RAW), 2048, WSP(float, WS_SMALL + SM_SSQ)}; pg8::gemm_phase(F.lds, g, S, E); } SEAM(6)
    PHASE(7) { RowCfg c{0, 4096, 5, 0, 6, 8192, 6144, 0, 0, 0, P.in[0], nullptr}; row_phase<true, true, false>(F, c); } SEAM(7)
    PHASE(8) { pg8::Gemm g{WSP(bf16_t, WS_H), WPTR(W_GU0), SEQ, 11264, 2048}; pg8::StaticOrder S; S.init(SEQ, 11264, F.G, F.bid); pg8::EpiSwiglu E{WSP(bf16_t, WS_BIG + B_HID), FFH}; pg8::gemm_phase(F.lds, g, S, E); } SEAM(8)
    PHASE(9) { pg8::Gemm g{WSP(bf16_t, WS_BIG + B_HID), WPTR(W_DN0), SEQ, 2048, FFH}; pg8::StaticOrder S; S.init(SEQ, 2048, F.G, F.bid); pg8::EpiRaw E{WSP(bf16_t, WS_RAW), 2048, WSP(float, WS_SMALL + SM_SSQ)}; pg8::gemm_phase(F.lds, g, S, E); } SEAM(9)
    PHASE(10) { RowCfg c{0, 10240, 7, 1, 29, 2048, 0, 33, 6160, 6144, P.out, WSP(float, WS_SMALL + SM_GLOW)};
                row_phase<true, true, true>(F, c); } SEAM(10)
    PHASE(11) { pg8::Gemm g{WSP(bf16_t, WS_H), WPTR(W_IN1), SEQ, 6144, 2048}; pg8::StaticOrder S; S.init(SEQ, 6144, F.G, F.bid); pg8::EpiBf16Store E{WSP(bf16_t, WS_BIG + B_Y), 6144}; pg8::gemm_phase(F.lds, g, S, E); } SEAM(11)
    PHASE(12) { if (F.bid == 0 && F.tid < 8) WSP(int, WS_SMALL + SM_PROG)[(8 + F.tid) * 64] = 0; for (int un = F.bid; un < 1024; un += F.G) gla_local_unit(F, un & 3, un >> 2); } SEAM(12)
    PHASE(13) { if (F.bid < 128) gla_scan_wg(F, F.bid & 3, F.bid >> 2); else if (F.bid < 224) convert_layer1_rest_idle(F, 128, 224); else gla_warm_wg(F, F.bid & 7, (F.bid - 224) >> 3); } SEAM(13)
    PHASE(14) { gla_finalize(F); } SEAM(14)
    PHASE(15) { pg8::Gemm g{WSP(bf16_t, WS_CAT), WPTR(W_OUT1), SEQ, 2048, 2048}; pg8::StaticOrder S; S.init(SEQ, 2048, F.G, F.bid); pg8::EpiRaw E{WSP(bf16_t, WS_RAW), 2048, WSP(float, WS_SMALL + SM_SSQ)}; pg8::gemm_phase(F.lds, g, S, E); } SEAM(15)
    PHASE(16) { RowCfg c{1, 4096, 30, 1, 31, 8192, 6144, 0, 0, 0, P.out, nullptr}; row_phase<true, true, false>(F, c); } SEAM(16)
    PHASE(17) { pg8::Gemm g{WSP(bf16_t, WS_H), WPTR(W_GU1), SEQ, 11264, 2048}; pg8::StaticOrder S; S.init(SEQ, 11264, F.G, F.bid); pg8::EpiSwiglu E{WSP(bf16_t, WS_BIG + B_HID), FFH}; pg8::gemm_phase(F.lds, g, S, E); } SEAM(17)
    PHASE(18) { pg8::Gemm g{WSP(bf16_t, WS_BIG + B_HID), WPTR(W_DN1), SEQ, 2048, FFH}; pg8::StaticOrder S; S.init(SEQ, 2048, F.G, F.bid); pg8::EpiRaw E{WSP(bf16_t, WS_RAW), 2048, WSP(float, WS_SMALL + SM_SSQ)}; pg8::gemm_phase(F.lds, g, S, E); } SEAM(18)
    PHASE(19) { RowCfg c{1, 10240, 32, 1, 0, 0, 0, 0, 0, 0, P.out, nullptr}; row_phase<true, false, false>(F, c); }
}

extern "C" void kernel_launch(void* const* d_in, const int* in_sizes, int n_in, void* d_out, int out_size, void* d_ws, size_t ws_size, hipStream_t stream) {
    static int grid = 0;
    if (grid == 0) {
        if (n_in != 41 || ws_size < WS_END) { fprintf(stderr, "kernel_launch: unexpected n_in %d / ws_size %zu (need %zu)\n", n_in, ws_size, (size_t)WS_END); grid = -1; return; }
        int dev = 0, cus = 0, per_cu = 0;
        hipGetDevice(&dev); hipDeviceGetAttribute(&cus, hipDeviceAttributeMultiprocessorCount, dev);
        if (hipFuncSetAttribute((const void*)fwd_megakernel, hipFuncAttributeMaxDynamicSharedMemorySize, LDS_BYTES) != hipSuccess) { fprintf(stderr, "kernel_launch: hipFuncSetAttribute failed\n"); grid = -1; return; }
        hipOccupancyMaxActiveBlocksPerMultiprocessor(&per_cu, (const void*)fwd_megakernel, 512, LDS_BYTES);
        (void)hipGetLastError();
        if (per_cu < 1) per_cu = 1;
        grid = cus * 1;
        fprintf(stderr, "kernel_launch: cus %d per_cu %d grid %d ws %zu\n", cus, per_cu, grid, ws_size);
    }
    if (grid < 0) return;
    Params p{};
    for (int i = 0; i < 41; ++i) p.in[i] = (const float*)d_in[i];
    p.out = (float*)d_out; p.ws = (unsigned char*)d_ws;
#if MK_SINGLE_LAUNCH
    p.ph_lo = 0; p.ph_hi = NPHASE;
    (void)hipMemsetAsync((char*)d_ws + WS_SMALL + SM_XBAR, 0, 3456 * 4, stream);
    void* args[] = {&p};
    hipError_t e = hipLaunchCooperativeKernel((const void*)fwd_megakernel, dim3(grid), dim3(512), args, LDS_BYTES, stream);
    if (e != hipSuccess) fprintf(stderr, "cooperative launch failed: %s (grid %d)\n", hipGetErrorString(e), grid);
#else
    static const int HREP[NPHASE] = {1,1,1,1,1, 1,1,1,1,1, 1,1,1,1,1, 1,1,1,1,1};
    static const int M4[4] = {M4LIST};
    for (int ph = 0; ph < NPHASE; ++ph) for (int r = 0; r < HREP[ph]; ++r) {
        p.ph_lo = ph; p.ph_hi = ph + 1; p.mode4 = (ph == 4) ? M4[r] : 0;
        hipLaunchKernelGGL(fwd_megakernel, dim3(grid), dim3(512), LDS_BYTES, stream, p);
    }
#endif
}
```

```cpp
#include <hip/hip_runtime.h>
#include <hip/hip_cooperative_groups.h>
#include <cstdio>
#include <cstdint>
namespace cg = cooperative_groups;

#ifndef MK_SINGLE_LAUNCH
#define MK_SINGLE_LAUNCH 1
#define M4LIST 0,0,0,0
#endif

#define LAS __attribute__((address_space(3)))
typedef unsigned short bf16_t;
typedef short bf16x8 __attribute__((ext_vector_type(8)));
typedef float f32x4 __attribute__((ext_vector_type(4)));
typedef float f32x2 __attribute__((ext_vector_type(2)));
typedef unsigned u32x4 __attribute__((ext_vector_type(4)));
typedef unsigned u32x2 __attribute__((ext_vector_type(2)));

constexpr int SEQ = 16384, DM = 2048, FFH = 5632;
constexpr int NPHASE = 20;
constexpr float EPS = 1e-6f;
constexpr size_t MiB = 1ull << 20;
constexpr size_t WS_SMALL = 0, WS_W = 8 * MiB, WS_H = 108 * MiB, WS_RAW = 172 * MiB, WS_CAT = 300 * MiB, WS_BIG = 364 * MiB, WS_END = 684 * MiB;
constexpr size_t SM_MODP = 0;
constexpr size_t SM_AB = 1 * MiB;
constexpr size_t SM_GLOW = 2 * MiB;
constexpr size_t SM_SSQ = 3 * MiB;
constexpr size_t SM_A16 = 5 * MiB;
constexpr size_t SM_GG = 5 * MiB + 65536;
constexpr size_t SM_GLAST = 6 * MiB;
constexpr size_t SM_XBAR = 7 * MiB;
constexpr size_t SM_PROG = 5 * MiB + 131072;
constexpr size_t W_IN0 = 0, W_GLU = 24 * MiB, W_OUT0 = 26 * MiB, W_GU0 = 34 * MiB, W_DN0 = 78 * MiB;
constexpr size_t W_IN1 = 0, W_OUT1 = 24 * MiB, W_GU1 = 32 * MiB, W_DN1 = 76 * MiB;
constexpr size_t B_Y = 0;
constexpr size_t B_S5WT = 128 * MiB, B_S5KT = 132 * MiB, B_S5WU = 144 * MiB, B_S5XC = 176 * MiB;
constexpr size_t B_QE = 192 * MiB, B_OU = 224 * MiB, B_YG = 256 * MiB, B_UG = 288 * MiB;
constexpr size_t B_ATT = 192 * MiB, B_VT = 200 * MiB;
constexpr size_t B_HID = 0;
constexpr int LDS_BYTES = 163840;

struct Params { const float* in[41]; float* out; unsigned char* ws; int ph_lo, ph_hi, mode4, pad; };

__device__ __forceinline__ unsigned f2bf(float f) { unsigned u = __float_as_uint(f); return (u + 0x7fffu + ((u >> 16) & 1u)) >> 16; }
__device__ __forceinline__ float bf2f(unsigned short b) { return __uint_as_float(((unsigned)b) << 16); }
__device__ __forceinline__ unsigned pk2(float lo, float hi) { return f2bf(lo) | (f2bf(hi) << 16); }
__device__ __forceinline__ unsigned cvt_pk_bf16(float lo, float hi) { unsigned r; asm volatile("v_cvt_pk_bf16_f32 %0, %1, %2" : "=v"(r) : "v"(lo), "v"(hi)); return r; }
__device__ __forceinline__ float wave_sum(float v) {
#pragma unroll
    for (int o = 1; o < 64; o <<= 1) v += __shfl_xor(v, o);
    return v;
}
__device__ __forceinline__ float sigmoidf_(float x) { return __builtin_amdgcn_rcpf(1.0f + __expf(-x)); }
__device__ __forceinline__ float siluf_(float x) { return x * __builtin_amdgcn_rcpf(1.0f + __expf(-x)); }
#define LBAR() do { asm volatile("s_waitcnt lgkmcnt(0)" ::: "memory"); __builtin_amdgcn_s_barrier(); asm volatile("" ::: "memory"); } while (0)
__device__ __forceinline__ f32x4 mfma16(bf16x8 a, bf16x8 b, f32x4 c) { return __builtin_amdgcn_mfma_f32_16x16x32_bf16(a, b, c, 0, 0, 0); }

namespace pg8 {
constexpr int BM = 256, BK = 64, HALF = 128, HTB = HALF * BK * 2, STAGE_BYTES = 8 * HTB, NXCD = 8, WGM = 8;
__host__ __device__ __forceinline__ int lds_byte(int r, int c) { const int st = (r >> 4) * 2 + (c >> 5), rr = r & 15, cc = c & 31, ob = rr * 64 + cc * 2; return st * 1024 + (ob ^ (((ob >> 9) & 1) << 5)); }
__host__ __device__ __forceinline__ void stage_rc(int b, int& R, int& C) { const int st = b / 1024, sb = b % 1024, swz = sb ^ (((sb >> 9) & 1) << 5); R = (st >> 1) * 16 + swz / 64; C = (st & 1) * 32 + (swz % 64) / 2; }
__host__ __device__ __forceinline__ int perm32(int rho) { const int n = rho >> 4, i = rho & 15; return 8 * (i >> 2) + 4 * n + (i & 3); }
struct Unit { int pm, pn; };
struct Gemm { const bf16_t* A; const bf16_t* Bt; int M, N, K; };
struct StaticOrder {
    int nM, nN, nwg, G, c;
    __device__ __forceinline__ void init(int M, int N, int G_, int c_) { nM = M / BM; nN = N / BM; nwg = nM * nN; G = G_; c = c_; }
    __device__ bool next(int i, Unit& u) const {
        const long L = (long)i * G + c; if (L >= nwg) return false;
        int wgid = (int)L; { const int q = nwg / NXCD, r = nwg % NXCD, xcd = wgid % NXCD, off = wgid / NXCD; wgid = (xcd < r ? xcd * (q + 1) : r * (q + 1) + (xcd - r) * q) + off; }
        const int nig = WGM * nN, gid = wgid / nig, fm = gid * WGM, gsz = (nM - fm) < WGM ? (nM - fm) : WGM;
        u.pm = fm + ((wgid % nig) % gsz); u.pn = (wgid % nig) / gsz; return true;
    }
};
struct EpiBf16Store {
    static constexpr bool PERM = true;
    bf16_t* O; int ldc;
    __device__ __forceinline__ void operator()(const f32x4 (&acc)[2][2][4][2], const Unit& u, int wr, int wc, int fr, int fq) const {
        const int row0 = u.pm * BM + wr * 64 + fr, col0 = u.pn * BM + wc * 32 + 8 * fq;
#pragma unroll
        for (int ai = 0; ai < 2; ++ai)
#pragma unroll
            for (int m = 0; m < 4; ++m) { bf16_t* rowp = O + (size_t)(row0 + ai * HALF + m * 16) * ldc + col0;
#pragma unroll
                for (int bj = 0; bj < 2; ++bj) { const f32x4 v0 = acc[ai][bj][m][0], v1 = acc[ai][bj][m][1];
                    u32x4 w; w.x = cvt_pk_bf16(v0[0], v0[1]); w.y = cvt_pk_bf16(v0[2], v0[3]); w.z = cvt_pk_bf16(v1[0], v1[1]); w.w = cvt_pk_bf16(v1[2], v1[3]);
                    *(u32x4*)(rowp + bj * HALF) = w; } }
    }
};
struct EpiIn0 {
    static constexpr bool PERM = true;
    bf16_t* O; int ldc; bf16_t* UG;
    __device__ __forceinline__ void operator()(const f32x4 (&acc)[2][2][4][2], const Unit& u, int wr, int wc, int fr, int fq) const {
        const int row0 = u.pm * BM + wr * 64 + fr, col0 = u.pn * BM + wc * 32 + 8 * fq;
#pragma unroll
        for (int ai = 0; ai < 2; ++ai)
#pragma unroll
            for (int m = 0; m < 4; ++m) { const int r = row0 + ai * HALF + m * 16;
#pragma unroll
                for (int bj = 0; bj < 2; ++bj) { const f32x4 v0 = acc[ai][bj][m][0], v1 = acc[ai][bj][m][1]; const int col = col0 + bj * HALF;
                    u32x4 w; w.x = cvt_pk_bf16(v0[0], v0[1]); w.y = cvt_pk_bf16(v0[2], v0[3]); w.z = cvt_pk_bf16(v1[0], v1[1]); w.w = cvt_pk_bf16(v1[2], v1[3]);
                    bf16_t* dst = (u.pn < 4) ? (UG + ((size_t)(col >> 4) * SEQ + r) * 16 + (col & 15)) : (O + (size_t)r * ldc + col);
                    *(u32x4*)dst = w; } }
    }
};
struct EpiGlu {
    static constexpr bool PERM = true;
    bf16_t* O; int ldc; const bf16_t* Y; int ldy; const float* bias;
    __device__ __forceinline__ void operator()(const f32x4 (&acc)[2][2][4][2], const Unit& u, int wr, int wc, int fr, int fq) const {
        const int row0 = u.pm * BM + wr * 64 + fr, col0 = u.pn * BM + wc * 32 + 8 * fq;
        f32x4 bv[2][2];
#pragma unroll
        for (int bj = 0; bj < 2; ++bj)
#pragma unroll
            for (int n = 0; n < 2; ++n) bv[bj][n] = *(const f32x4*)(bias + col0 + bj * HALF + 4 * n);
#pragma unroll
        for (int ai = 0; ai < 2; ++ai)
#pragma unroll
            for (int m = 0; m < 4; ++m) { const size_t r = (size_t)(row0 + ai * HALF + m * 16);
#pragma unroll
                for (int bj = 0; bj < 2; ++bj) {
                    const u32x4 yv = *(const u32x4*)(Y + r * ldy + col0 + bj * HALF);
                    const f32x4 v0 = acc[ai][bj][m][0] + bv[bj][0], v1 = acc[ai][bj][m][1] + bv[bj][1];
                    float o[8];
                    const unsigned yy[4] = {yv.x, yv.y, yv.z, yv.w};
#pragma unroll
                    for (int j = 0; j < 4; ++j) { const float ylo = __uint_as_float(yy[j] << 16), yhi = __uint_as_float(yy[j] & 0xffff0000u);
                        const float a0 = (j < 2) ? v0[2 * j] : v1[2 * j - 4], a1 = (j < 2) ? v0[2 * j + 1] : v1[2 * j - 3];
                        o[2 * j] = ylo * sigmoidf_(a0); o[2 * j + 1] = yhi * sigmoidf_(a1); }
                    u32x4 w; w.x = cvt_pk_bf16(o[0], o[1]); w.y = cvt_pk_bf16(o[2], o[3]); w.z = cvt_pk_bf16(o[4], o[5]); w.w = cvt_pk_bf16(o[6], o[7]);
                    *(u32x4*)(O + r * ldc + col0 + bj * HALF) = w; } }
    }
};
struct EpiSwiglu {
    static constexpr bool PERM = true;
    bf16_t* O; int ldc;
    __device__ __forceinline__ void operator()(const f32x4 (&acc)[2][2][4][2], const Unit& u, int wr, int wc, int fr, int fq) const {
        const int row0 = u.pm * BM + wr * 64 + fr, col0 = u.pn * HALF + wc * 32 + 8 * fq;
#pragma unroll
        for (int ai = 0; ai < 2; ++ai)
#pragma unroll
            for (int m = 0; m < 4; ++m) { bf16_t* rowp = O + (size_t)(row0 + ai * HALF + m * 16) * ldc + col0;
                float o[8];
#pragma unroll
                for (int n = 0; n < 2; ++n)
#pragma unroll
                    for (int j = 0; j < 4; ++j) { const float g = acc[ai][0][m][n][j], up = acc[ai][1][m][n][j]; o[4 * n + j] = siluf_(g) * up; }
                u32x4 w; w.x = cvt_pk_bf16(o[0], o[1]); w.y = cvt_pk_bf16(o[2], o[3]); w.z = cvt_pk_bf16(o[4], o[5]); w.w = cvt_pk_bf16(o[6], o[7]);
                *(u32x4*)rowp = w; }
    }
};
struct EpiRaw {
    static constexpr bool PERM = true;
    bf16_t* C; int ldc; float* ssq;
    __device__ __forceinline__ void operator()(const f32x4 (&acc)[2][2][4][2], const Unit& u, int wr, int wc, int fr, int fq) const {
        const int row0 = u.pm * BM + wr * 64 + fr, col0 = u.pn * BM + wc * 32 + 8 * fq;
#pragma unroll
        for (int ai = 0; ai < 2; ++ai)
#pragma unroll
            for (int m = 0; m < 4; ++m) { const int r = row0 + ai * HALF + m * 16; bf16_t* rowp = C + (size_t)r * ldc + col0; float s = 0.f;
#pragma unroll
                for (int bj = 0; bj < 2; ++bj) { const f32x4 v0 = acc[ai][bj][m][0], v1 = acc[ai][bj][m][1];
                    s += (v0[0] * v0[0] + v0[1] * v0[1]) + (v0[2] * v0[2] + v0[3] * v0[3]) + (v1[0] * v1[0] + v1[1] * v1[1]) + (v1[2] * v1[2] + v1[3] * v1[3]);
                    u32x4 w; w.x = cvt_pk_bf16(v0[0], v0[1]); w.y = cvt_pk_bf16(v0[2], v0[3]); w.z = cvt_pk_bf16(v1[0], v1[1]); w.w = cvt_pk_bf16(v1[2], v1[3]);
                    *(u32x4*)(rowp + bj * HALF) = w; }
                s += __shfl_xor(s, 16); s += __shfl_xor(s, 32);
                if (fq == 0) ssq[(size_t)r * 32 + u.pn * 4 + wc] = s; }
    }
};

template <class Epi>
__device__ __forceinline__ void gemm_phase(LAS unsigned char* lds, const Gemm g, const StaticOrder& S, const Epi& E) {
    const int tid = threadIdx.x, wid = __builtin_amdgcn_readfirstlane(tid >> 6), lane = tid & 63, wr = wid >> 2, wc = wid & 3, fr = lane & 15, fq = lane >> 4;
    const int K = g.K, nt = K / BK;
    unsigned voffA[2], voffB[2];
#pragma unroll
    for (int i = 0; i < 2; ++i) { int R, C; stage_rc(tid * 16 + i * 8192, R, C); const int Rb = Epi::PERM ? ((R & ~31) + perm32(R & 31)) : R;
        voffA[i] = (unsigned)(R * K + C) * 2u; voffB[i] = (unsigned)(Rb * K + C) * 2u; }
    const size_t kstep = (size_t)(BK * 2);
    const size_t hstep = (size_t)HALF * K * 2;
    const size_t tstep = 2 * hstep;
    const unsigned ldsw = (unsigned)wid * 1024u;
    const int aoff = lds_byte(wr * 64 + fr, fq * 8), boff = lds_byte(wc * 32 + fr, fq * 8);
#define PG8_SA(b, h) (((b) * 2 + (h)) * HTB)
#define PG8_SB(b, h) ((4 + (b) * 2 + (h)) * HTB)
#define PG8_STAGE(bufoff, gbase, voff) do { _Pragma("unroll") for (int _i = 0; _i < 2; ++_i) \
        __builtin_amdgcn_global_load_lds((const unsigned*)((const char*)(gbase) + (voff)[_i]), (LAS unsigned*)(lds + (bufoff) + ldsw + _i * 8192), 16, 0, 0); } while (0)
#define PG8_LDA(dst, b, h) do { _Pragma("unroll") for (int m = 0; m < 4; ++m) _Pragma("unroll") for (int k = 0; k < 2; ++k) dst[m][k] = *(const LAS bf16x8*)(lds + PG8_SA(b, h) + aoff + m * 2048 + k * 1024); } while (0)
#define PG8_LDB(dst, b, h) do { _Pragma("unroll") for (int n = 0; n < 2; ++n) _Pragma("unroll") for (int k = 0; k < 2; ++k) dst[n][k] = *(const LAS bf16x8*)(lds + PG8_SB(b, h) + boff + n * 2048 + k * 1024); } while (0)
#define PG8_MMA(ai, bj, At, Bt) do { __builtin_amdgcn_s_setprio(1); _Pragma("unroll") for (int m = 0; m < 4; ++m) _Pragma("unroll") for (int n = 0; n < 2; ++n) _Pragma("unroll") for (int k = 0; k < 2; ++k) \
        acc[ai][bj][m][n] = __builtin_amdgcn_mfma_f32_16x16x32_bf16(Bt[n][k], At[m][k], acc[ai][bj][m][n], 0, 0, 0); __builtin_amdgcn_s_setprio(0); } while (0)
#define PG8_WAIT_V(n) asm volatile("s_waitcnt vmcnt(" #n ")" ::: "memory")
#define PG8_WAIT_L(n) asm volatile("s_waitcnt lgkmcnt(" #n ")" ::: "memory")
#define PG8_BAR __builtin_amdgcn_s_barrier()
#define PG8_SCHED __builtin_amdgcn_sched_barrier(0)
    Unit cur, nxt; int ui = 0;
    if (!S.next(0, cur)) return;
    f32x4 acc[2][2][4][2];
#pragma unroll
    for (int a = 0; a < 2; ++a)
#pragma unroll
        for (int b = 0; b < 2; ++b)
#pragma unroll
            for (int m = 0; m < 4; ++m)
#pragma unroll
                for (int n = 0; n < 2; ++n) acc[a][b][m][n] = (f32x4){0.f, 0.f, 0.f, 0.f};
    bf16x8 At[4][2], B0[2][2], B1[2][2];
    const char* cA = (const char*)g.A + (size_t)cur.pm * tstep; const char* cB = (const char*)g.Bt + (size_t)cur.pn * tstep;
    PG8_STAGE(PG8_SB(0, 0), cB, voffB); PG8_STAGE(PG8_SB(0, 1), cB + hstep, voffB); PG8_STAGE(PG8_SA(0, 0), cA, voffA); PG8_STAGE(PG8_SA(0, 1), cA + hstep, voffA);
    if (wr == 1) PG8_BAR;
    PG8_WAIT_V(2); PG8_BAR;
    PG8_STAGE(PG8_SB(1, 0), cB + kstep, voffB); PG8_STAGE(PG8_SA(1, 0), cA + kstep, voffA); PG8_STAGE(PG8_SB(1, 1), cB + hstep + kstep, voffB);
    PG8_WAIT_V(6); PG8_BAR;
    for (;;) {
        const bool has_next = S.next(ui + 1, nxt);
        const char* nA = has_next ? (const char*)g.A + (size_t)nxt.pm * tstep : cA; const char* nB = has_next ? (const char*)g.Bt + (size_t)nxt.pn * tstep : cB;
        for (int t = 0; t < nt; t += 2) {
            const bool last = (t == nt - 2);
            const char* a1 = cA + (size_t)(t + 1) * kstep;
            const char* a2 = last ? nA : cA + (size_t)(t + 2) * kstep; const char* b2 = last ? nB : cB + (size_t)(t + 2) * kstep;
            const char* a3 = a2 + kstep; const char* b3 = b2 + kstep;
            PG8_LDB(B0, 0, 0); PG8_LDB(B1, 0, 1); PG8_SCHED; PG8_LDA(At, 0, 0); PG8_STAGE(PG8_SA(1, 1), a1 + hstep, voffA);
            PG8_WAIT_V(8); PG8_WAIT_L(0); PG8_BAR; PG8_MMA(0, 0, At, B0); PG8_MMA(0, 1, At, B1); PG8_BAR; PG8_SCHED;
            PG8_LDA(At, 0, 1); PG8_STAGE(PG8_SB(0, 0), b2, voffB); PG8_STAGE(PG8_SB(0, 1), b2 + hstep, voffB); PG8_STAGE(PG8_SA(0, 0), a2, voffA);
            PG8_WAIT_V(8); PG8_WAIT_L(0); PG8_BAR; PG8_MMA(1, 0, At, B0); PG8_MMA(1, 1, At, B1); PG8_BAR; PG8_SCHED;
            PG8_LDB(B0, 1, 0); PG8_LDB(B1, 1, 1); PG8_SCHED; PG8_LDA(At, 1, 0); PG8_STAGE(PG8_SA(0, 1), a2 + hstep, voffA);
            PG8_WAIT_V(8); PG8_WAIT_L(0); PG8_BAR; PG8_MMA(0, 0, At, B0); PG8_MMA(0, 1, At, B1); PG8_BAR; PG8_SCHED;
            PG8_LDA(At, 1, 1); PG8_STAGE(PG8_SB(1, 0), b3, voffB); PG8_STAGE(PG8_SB(1, 1), b3 + hstep, voffB); PG8_STAGE(PG8_SA(1, 0), a3, voffA);
            PG8_WAIT_V(8); PG8_WAIT_L(0); PG8_BAR; PG8_MMA(1, 0, At, B0); PG8_MMA(1, 1, At, B1); PG8_BAR; PG8_SCHED;
        }
        if (wr == 0) PG8_BAR;
        E(acc, cur, wr, wc, fr, fq);
        if (!has_next) break;
#pragma unroll
        for (int a = 0; a < 2; ++a)
#pragma unroll
            for (int b = 0; b < 2; ++b)
#pragma unroll
                for (int m = 0; m < 4; ++m)
#pragma unroll
                    for (int n = 0; n < 2; ++n) acc[a][b][m][n] = (f32x4){0.f, 0.f, 0.f, 0.f};
        cur = nxt; cA = nA; cB = nB; ++ui;
        if (wr == 1) PG8_BAR;
    }
    PG8_WAIT_V(0);
    PG8_BAR;
#undef PG8_SA
#undef PG8_SB
#undef PG8_STAGE
#undef PG8_LDA
#undef PG8_LDB
#undef PG8_MMA
#undef PG8_WAIT_V
#undef PG8_WAIT_L
#undef PG8_BAR
#undef PG8_SCHED
}
}

struct Ctx {
    LAS unsigned char* lds;
    int tid, lane, wave, G, bid;
    const Params* p;
};
#define WSP(T, off) ((T*)(P.ws + (off)))

template <bool SWAP>
__device__ __forceinline__ f32x4 tile_mm(const LAS bf16_t* A, int lda, const LAS bf16_t* B, int ldb, int m0, int n0, int ksteps, int fr, int fq) {
    f32x4 acc = (f32x4){0.f, 0.f, 0.f, 0.f};
    for (int ks = 0; ks < ksteps; ++ks) {
        const bf16x8 a = *(const LAS bf16x8*)(A + (m0 + fr) * lda + ks * 32 + fq * 8);
        const bf16x8 b = *(const LAS bf16x8*)(B + (n0 + fr) * ldb + ks * 32 + fq * 8);
        acc = SWAP ? mfma16(b, a, acc) : mfma16(a, b, acc);
    }
    return acc;
}

__device__ __forceinline__ void transpose_item(const float* W, int K, int Nsrc, int c0, bf16_t* WT, int mode, LAS float* scr, int kb, int nb, int lane) {
    const int k0 = 64 * kb, n0 = 32 * nb;
#pragma unroll 8
    for (int i = 0; i < 32; ++i) { const int kk = 2 * i + (lane >> 5); scr[kk * 33 + (lane & 31)] = W[(size_t)(k0 + kk) * Nsrc + c0 + n0 + (lane & 31)]; }
    asm volatile("s_waitcnt lgkmcnt(0)" ::: "memory");
    const int c = lane & 7;
#pragma unroll
    for (int j = 0; j < 4; ++j) { const int n = (lane >> 3) + 8 * j; const LAS float* s = scr + (8 * c) * 33 + n;
        u32x4 o; o.x = pk2(s[0 * 33], s[1 * 33]); o.y = pk2(s[2 * 33], s[3 * 33]); o.z = pk2(s[4 * 33], s[5 * 33]); o.w = pk2(s[6 * 33], s[7 * 33]);
        const int nn = n0 + n; const int row = (mode == 0) ? nn : ((nn >> 7) * 256 + (nn & 127) + (mode == 2 ? 128 : 0));
        *(u32x4*)(WT + (size_t)row * K + k0 + 8 * c) = o; }
    asm volatile("s_waitcnt lgkmcnt(0)" ::: "memory");
}
__device__ __forceinline__ void tr_job(const Ctx& F, int& base, const float* W, int K, int Nsrc, int c0, int ncols, int mode, bf16_t* WT, LAS float* scr, int gw = -1, int NGW = 0) {
    if (gw < 0) { gw = F.bid * 8 + F.wave; NGW = F.G * 8; }
    const int nnb = ncols / 32, items = (K / 64) * nnb;
    const int first = (gw - base % NGW + NGW) % NGW;
    for (int it = first; it < items; it += NGW) transpose_item(W, K, Nsrc, c0, WT, mode, scr, it / nnb, it % nnb, F.lane);
    base += items;
}

__device__ __forceinline__ void s5_precompute(const Ctx& F, int g) {
    const Params& P = *F.p;
    LAS float* AP = (LAS float*)F.lds;
    LAS float* BB = AP + 17 * 128;
    LAS float* CC = BB + 2048;
    LAS float* KD = CC + 2048;
    LAS float* FF = KD + 4096;
    const int tid = F.tid;
    if (tid < 64) {
        const int n = tid; const float lr = P.in[9][g * 64 + n], li = P.in[10][g * 64 + n], dt = expf(P.in[11][g]);
        const float mag = expf(lr * dt); float sn, cs; sincosf(li * dt, &sn, &cs);
        const float ar = mag * cs, ai = mag * sn, den = lr * lr + li * li, nr = ar - 1.0f, ni = ai;
        FF[2 * n] = (nr * lr + ni * li) / den; FF[2 * n + 1] = (ni * lr - nr * li) / den;
        float pr = 1.f, pi = 0.f;
        for (int d = 0; d <= 16; ++d) { AP[(d * 64 + n) * 2] = pr; AP[(d * 64 + n) * 2 + 1] = pi; const float tr = pr * ar - pi * ai, ti = pr * ai + pi * ar; pr = tr; pi = ti; }
        float* A16 = WSP(float, WS_SMALL + SM_A16) + g * 128;
        A16[n] = AP[(16 * 64 + n) * 2]; A16[64 + n] = AP[(16 * 64 + n) * 2 + 1];
    }
    __syncthreads();
    for (int idx = tid; idx < 1024; idx += 512) {
        const int n = idx >> 4, q = idx & 15; const float br = P.in[12][(g * 64 + n) * 16 + q], bi = P.in[13][(g * 64 + n) * 16 + q], fr_ = FF[2 * n], fi_ = FF[2 * n + 1];
        BB[idx * 2] = fr_ * br - fi_ * bi; BB[idx * 2 + 1] = fr_ * bi + fi_ * br;
        const int p = idx >> 6, nn = idx & 63;
        CC[idx * 2] = P.in[14][(g * 16 + p) * 64 + nn]; CC[idx * 2 + 1] = P.in[15][(g * 16 + p) * 64 + nn];
    }
    __syncthreads();
    for (int idx = tid; idx < 4096; idx += 512) {
        const int d = idx >> 8, p = (idx >> 4) & 15, q = idx & 15; float s = 0.f;
        for (int n = 0; n < 64; ++n) { const float cr = CC[(p * 64 + n) * 2], ci = CC[(p * 64 + n) * 2 + 1], ar = AP[(d * 64 + n) * 2], ai = AP[(d * 64 + n) * 2 + 1], br = BB[(n * 16 + q) * 2], bi = BB[(n * 16 + q) * 2 + 1];
            const float zr = cr * ar - ci * ai, zi = cr * ai + ci * ar; s += zr * br - zi * bi; }
        if (d == 0 && p == q) s += P.in[16][g * 16 + p];
        KD[idx] = s;
    }
    __syncthreads();
    bf16_t* KT = WSP(bf16_t, WS_BIG + B_S5KT) + (size_t)g * 256 * 384;
    for (int ch = tid; ch < 256 * 48; ch += 512) {
        const int n = ch / 48, k0 = (ch % 48) * 8, t = n >> 4, p = n & 15; float v[8];
#pragma unroll
        for (int j = 0; j < 8; ++j) { const int k = k0 + j;
            if (k < 256) { const int s = k >> 4, q = k & 15; v[j] = (s <= t) ? KD[((t - s) * 16 + p) * 16 + q] : 0.f; }
            else { const int kk = k - 256, nn = kk & 63; const float cr = CC[(p * 64 + nn) * 2], ci = CC[(p * 64 + nn) * 2 + 1], ar = AP[((t + 1) * 64 + nn) * 2], ai = AP[((t + 1) * 64 + nn) * 2 + 1];
                v[j] = (kk < 64) ? (cr * ar - ci * ai) : -(cr * ai + ci * ar); } }
        u32x4 o; o.x = pk2(v[0], v[1]); o.y = pk2(v[2], v[3]); o.z = pk2(v[4], v[5]); o.w = pk2(v[6], v[7]);
        *(u32x4*)(KT + (size_t)n * 384 + k0) = o;
    }
    bf16_t* WT = WSP(bf16_t, WS_BIG + B_S5WT) + (size_t)g * 128 * 256;
    for (int ch = tid; ch < 128 * 32; ch += 512) {
        const int np = ch / 32, k0 = (ch % 32) * 8, n = np & 63; float v[8];
#pragma unroll
        for (int j = 0; j < 8; ++j) { const int k = k0 + j, s = k >> 4, q = k & 15; const float ar = AP[((15 - s) * 64 + n) * 2], ai = AP[((15 - s) * 64 + n) * 2 + 1], br = BB[(n * 16 + q) * 2], bi = BB[(n * 16 + q) * 2 + 1];
            v[j] = (np < 64) ? (ar * br - ai * bi) : (ar * bi + ai * br); }
        u32x4 o; o.x = pk2(v[0], v[1]); o.y = pk2(v[2], v[3]); o.z = pk2(v[4], v[5]); o.w = pk2(v[6], v[7]);
        *(u32x4*)(WT + (size_t)np * 256 + k0) = o;
    }
    __syncthreads();
}

__device__ __forceinline__ void ada_gemv(const Ctx& F, const LAS float* sc, int layer, int gw, int NGW) {
    const Params& P = *F.p; float* MODP = WSP(float, WS_SMALL + SM_MODP);
    for (int task = gw; task < 192 * 8; task += NGW) {
        const int kp = task & 7, cb = task >> 3;
        const float* W = P.in[layer ? 27 : 2] + (size_t)(kp * 256) * 12288 + cb * 64 + F.lane;
        float acc = 0.f;
#pragma unroll 16
        for (int k = 0; k < 256; ++k) acc += sc[kp * 256 + k] * W[(size_t)k * 12288];
        MODP[(size_t)(kp * 2 + layer) * 12288 + cb * 64 + F.lane] = acc;
    }
}
__device__ __forceinline__ void ada_gemv_layer1_idle(const Ctx& F, int first_idle, int end_idle) {
    const Params& P = *F.p;
    LAS float* sc = (LAS float*)F.lds;
    for (int k = F.tid; k < DM; k += 512) sc[k] = siluf_(P.in[1][k]);
    __syncthreads();
    ada_gemv(F, sc, 1, (F.bid - first_idle) * 8 + F.wave, (end_idle - first_idle) * 8);
    __syncthreads();
    LAS float* scr = (LAS float*)F.lds + F.wave * (64 * 33);
    char* Wb = (char*)WSP(bf16_t, WS_W); int base = 0; const int gw = (F.bid - first_idle) * 8 + F.wave, NGW = (end_idle - first_idle) * 8;
    tr_job(F, base, P.in[23], 2048, 2048, 0, 2048, 0, (bf16_t*)(Wb + W_OUT0), scr, gw, NGW);
    tr_job(F, base, P.in[26], 5632, 2048, 0, 2048, 0, (bf16_t*)(Wb + W_DN0), scr, gw, NGW);
    tr_job(F, base, P.in[33], 2048, 6160, 0, 6144, 0, (bf16_t*)(Wb + W_IN1), scr, gw, NGW);
}
__device__ __forceinline__ void phase_prologue(const Ctx& F) {
    const Params& P = *F.p;
    if (F.bid < 64) s5_precompute(F, F.bid);
    LAS float* sc = (LAS float*)F.lds;
    for (int k = F.tid; k < DM; k += 512) sc[k] = siluf_(P.in[1][k]);
    __syncthreads();
    if (F.bid >= 64) ada_gemv(F, sc, 0, (F.bid - 64) * 8 + F.wave, (F.G - 64) * 8);
    __syncthreads();
    LAS float* scr = (LAS float*)F.lds + F.wave * (64 * 33);
    char* Wb = (char*)WSP(bf16_t, WS_W); int base = 0;
    tr_job(F, base, P.in[8], 2048, 4112, 0, 4096, 0, (bf16_t*)(Wb + W_IN0), scr);
    tr_job(F, base, P.in[17], 1024, 1024, 0, 1024, 0, (bf16_t*)(Wb + W_GLU), scr);
    tr_job(F, base, P.in[24], 2048, 5632, 0, 5632, 1, (bf16_t*)(Wb + W_GU0), scr);
    tr_job(F, base, P.in[25], 2048, 5632, 0, 5632, 2, (bf16_t*)(Wb + W_GU0), scr);
}
__device__ __forceinline__ void convert_layer1_in(const Ctx& F) {
    const Params& P = *F.p;
    LAS float* scr = (LAS float*)F.lds + F.wave * (64 * 33);
    char* Wb = (char*)WSP(bf16_t, WS_W); int base = 0;
    tr_job(F, base, P.in[33], 2048, 6160, 0, 6144, 0, (bf16_t*)(Wb + W_IN1), scr);
}
__device__ __forceinline__ void convert_layer1_rest_idle(const Ctx& F, int first_idle, int end_idle) {
    const Params& P = *F.p;
    LAS float* scr = (LAS float*)F.lds + F.wave * (64 * 33);
    char* Wb = (char*)WSP(bf16_t, WS_W); int base = 0; const int gw = (F.bid - first_idle) * 8 + F.wave, NGW = (end_idle - first_idle) * 8;
    tr_job(F, base, P.in[37], 2048, 2048, 0, 2048, 0, (bf16_t*)(Wb + W_OUT1), scr, gw, NGW);
    tr_job(F, base, P.in[38], 2048, 5632, 0, 5632, 1, (bf16_t*)(Wb + W_GU1), scr, gw, NGW);
    tr_job(F, base, P.in[39], 2048, 5632, 0, 5632, 2, (bf16_t*)(Wb + W_GU1), scr, gw, NGW);
    tr_job(F, base, P.in[40], 5632, 2048, 0, 2048, 0, (bf16_t*)(Wb + W_DN1), scr, gw, NGW);
}

__device__ __forceinline__ float treduce16(float (&t)[16], int lane) {
#pragma unroll
    for (int half = 8, off = 32; half >= 1; half >>= 1, off >>= 1) {
        const bool up = (lane & off) != 0;
#pragma unroll
        for (int i = 0; i < half; ++i) { const float a = t[i], b = t[i + half]; const float send = up ? a : b, keep = up ? b : a; t[i] = keep + __shfl_xor(send, off); }
    }
    float r = t[0]; r += __shfl_xor(r, 2); r += __shfl_xor(r, 1); return r;
}
struct RowCfg;
template <bool POST, bool PRE>
__device__ __forceinline__ void row_core(const Params& P, const RowCfg& c, LAS float* vA, LAS float* vB, LAS float* vP, const bf16_t* RAW, const float* SSQ, bf16_t* H, int row, int lane, f32x4 (&v)[8]);
struct RowCfg { int lpost, gt_off, wpost_in, lpre, wpre_in, sc_off, sh_off, thin_in, thin_nsrc, thin_c0; const float* xsrc; float* thin_out; };
template <bool POST, bool PRE>
__device__ __forceinline__ void row_core(const Params& P, const RowCfg& c, LAS float* vA, LAS float* vB, LAS float* vP, const bf16_t* RAW, const float* SSQ, bf16_t* H, int row, int lane, f32x4 (&v)[8]) {
    const f32x4* xs = (const f32x4*)(c.xsrc + (size_t)row * DM) + lane;
#pragma unroll
    for (int j = 0; j < 8; ++j) v[j] = xs[64 * j];
    if (POST) {
        const u32x2* rs = (const u32x2*)(RAW + (size_t)row * DM) + lane;
        float s = (lane < 32) ? SSQ[(size_t)row * 32 + lane] : 0.f; s = wave_sum(s);
        const float rstd = rsqrtf(s * (1.0f / DM) + EPS);
        f32x4* os = (f32x4*)(P.out + (size_t)row * DM) + lane;
#pragma unroll
        for (int j = 0; j < 8; ++j) { const u32x2 rb = rs[64 * j]; const f32x4 r = (f32x4){__uint_as_float(rb.x << 16), __uint_as_float(rb.x & 0xffff0000u), __uint_as_float(rb.y << 16), __uint_as_float(rb.y & 0xffff0000u)};
            const f32x4 pv = *(const LAS f32x4*)(vP + j * 256 + lane * 4); v[j] += r * rstd * pv; os[64 * j] = v[j]; }
    }
    if (PRE) {
        float s2 = 0.f;
#pragma unroll
        for (int j = 0; j < 8; ++j) s2 += (v[j][0] * v[j][0] + v[j][1] * v[j][1]) + (v[j][2] * v[j][2] + v[j][3] * v[j][3]);
        s2 = wave_sum(s2);
        const float rstd2 = rsqrtf(s2 * (1.0f / DM) + EPS);
        u32x2* hs = (u32x2*)(H + (size_t)row * DM) + lane;
#pragma unroll
        for (int j = 0; j < 8; ++j) { const f32x4 a = *(const LAS f32x4*)(vA + j * 256 + lane * 4), b = *(const LAS f32x4*)(vB + j * 256 + lane * 4);
            v[j] = v[j] * rstd2 * a + b; u32x2 w; w.x = cvt_pk_bf16(v[j][0], v[j][1]); w.y = cvt_pk_bf16(v[j][2], v[j][3]); hs[64 * j] = w; }
    }
}
template <bool POST, bool PRE, bool THIN>
__device__ __forceinline__ void row_phase(const Ctx& F, const RowCfg c) {
    const Params& P = *F.p;
    LAS float* vA = (LAS float*)F.lds; LAS float* vB = vA + 2048; LAS float* vP = vB + 2048; LAS float* tw = vP + 2048;
    const float* MODP = WSP(float, WS_SMALL + SM_MODP);
    const float* adab_post = P.in[c.lpost ? 28 : 3]; const float* adab_pre = P.in[c.lpre ? 28 : 3];
    for (int j = F.tid; j < DM; j += 512) {
        if (POST) { float g = adab_post[c.gt_off + j]; for (int pp = 0; pp < 8; ++pp) g += MODP[(size_t)(pp * 2 + c.lpost) * 12288 + c.gt_off + j]; vP[j] = g * P.in[c.wpost_in][j]; }
        if (PRE) { float s = adab_pre[c.sc_off + j], h = adab_pre[c.sh_off + j];
            for (int pp = 0; pp < 8; ++pp) { s += MODP[(size_t)(pp * 2 + c.lpre) * 12288 + c.sc_off + j]; h += MODP[(size_t)(pp * 2 + c.lpre) * 12288 + c.sh_off + j]; }
            vA[j] = P.in[c.wpre_in][j] * (1.0f + s); vB[j] = h; }
    }
    if (THIN) { const float* W = P.in[c.thin_in]; for (int e = F.tid; e < 16 * 2048; e += 512) { const int k = e >> 4, cc = e & 15; tw[cc * 2048 + k] = W[(size_t)k * c.thin_nsrc + c.thin_c0 + cc]; } }
    __syncthreads();
    const int gw = F.bid * 8 + F.wave, NGW = F.G * 8, lane = F.lane;
    const bf16_t* RAW = WSP(bf16_t, WS_RAW); const float* SSQ = WSP(float, WS_SMALL + SM_SSQ); bf16_t* H = WSP(bf16_t, WS_H);
    if (!THIN) {
        for (int row = gw; row < SEQ; row += NGW) { f32x4 v[8]; row_core<POST, PRE>(P, c, vA, vB, vP, RAW, SSQ, H, row, lane, v); }
    } else {
        for (int row = gw; row < SEQ; row += 2 * NGW) {
            f32x4 v0[8], v1[8];
            const int rowB = row + NGW; const bool hasB = rowB < SEQ;
            row_core<POST, PRE>(P, c, vA, vB, vP, RAW, SSQ, H, row, lane, v0);
            if (hasB) row_core<POST, PRE>(P, c, vA, vB, vP, RAW, SSQ, H, rowB, lane, v1);
            else {
#pragma unroll
                for (int j = 0; j < 8; ++j) v1[j] = (f32x4){0.f, 0.f, 0.f, 0.f}; }
            float t0[16], t1[16];
#pragma unroll
            for (int cc = 0; cc < 16; ++cc) { float a0 = 0.f, a1 = 0.f;
#pragma unroll
                for (int j = 0; j < 8; ++j) { const f32x4 w = *(const LAS f32x4*)(tw + cc * 2048 + j * 256 + lane * 4);
                    a0 += (v0[j][0] * w[0] + v0[j][1] * w[1]) + (v0[j][2] * w[2] + v0[j][3] * w[3]);
                    a1 += (v1[j][0] * w[0] + v1[j][1] * w[1]) + (v1[j][2] * w[2] + v1[j][3] * w[3]); }
                t0[cc] = a0; t1[cc] = a1; }
            const float r0 = treduce16(t0, lane), r1 = treduce16(t1, lane);
            if ((lane & 3) == 0) { c.thin_out[(size_t)row * 16 + ((lane >> 2) & 15)] = r0; if (hasB) c.thin_out[(size_t)rowB * 16 + ((lane >> 2) & 15)] = r1; }
        }
    }
}

__device__ __forceinline__ void s5_wu_phase(const Ctx& F) {
    const Params& P = *F.p;
    const bf16_t* UG = WSP(bf16_t, WS_BIG + B_UG); const bf16_t* WTb = WSP(bf16_t, WS_BIG + B_S5WT); float* WU = WSP(float, WS_BIG + B_S5WU);
    const int gw = F.bid * 8 + F.wave, NGW = F.G * 8, lane = F.lane, fr = lane & 15, fq = lane >> 4;
    for (int task = gw; task < 64 * 64; task += NGW) {
        const int g = task >> 6, c0 = (task & 63) * 16;
        bf16x8 a[8];
#pragma unroll
        for (int ks = 0; ks < 8; ++ks) a[ks] = *(const bf16x8*)(UG + ((size_t)g * SEQ + (size_t)(c0 + fr) * 16) * 16 + ks * 32 + fq * 8);
        const bf16_t* WT = WTb + (size_t)g * 128 * 256;
#pragma unroll 2
        for (int nt = 0; nt < 8; ++nt) {
            f32x4 acc = (f32x4){0.f, 0.f, 0.f, 0.f};
#pragma unroll
            for (int ks = 0; ks < 8; ++ks) { const bf16x8 b = *(const bf16x8*)(WT + (size_t)(nt * 16 + fr) * 256 + ks * 32 + fq * 8); acc = mfma16(b, a[ks], acc); }
            *(f32x4*)(WU + ((size_t)g * 1024 + c0 + fr) * 128 + nt * 16 + fq * 4) = acc;
        }
    }
}
__device__ __forceinline__ float gelu_tanh(float x) { const float z = 0.7978845608028654f * (x + 0.044715f * x * x * x); const float e = __expf(2.0f * z); const float th = 1.0f - 2.0f * __builtin_amdgcn_rcpf(e + 1.0f); return 0.5f * x * (1.0f + th); }
__device__ __forceinline__ void s5_group_phase(const Ctx& F, int g) {
    const Params& P = *F.p;
    const bf16_t* UG = WSP(bf16_t, WS_BIG + B_UG) + (size_t)g * SEQ * 16; const float* WU = WSP(float, WS_BIG + B_S5WU) + (size_t)g * 1024 * 128;
    bf16_t* XC = WSP(bf16_t, WS_BIG + B_S5XC) + (size_t)g * 1024 * 128; const bf16_t* KT = WSP(bf16_t, WS_BIG + B_S5KT) + (size_t)g * 256 * 384;
    bf16_t* YG = WSP(bf16_t, WS_BIG + B_YG);
    const int tid = F.tid, lane = F.lane, fr = lane & 15, fq = lane >> 4;
    {
        LAS float* wu = (LAS float*)F.lds;
        LAS bf16_t* xs = (LAS bf16_t*)(F.lds + 65536);
        const float* A16 = WSP(float, WS_SMALL + SM_A16) + g * 128; const float ar = A16[lane], ai = A16[64 + lane]; float cr = 0.f, ci = 0.f;
        for (int blk = 0; blk < 8; ++blk) {
            f32x4 t[8];
#pragma unroll
            for (int i = 0; i < 8; ++i) t[i] = *(const f32x4*)(WU + (size_t)blk * 16384 + (size_t)(i * 512 + tid) * 4);
#pragma unroll
            for (int i = 0; i < 8; ++i) *(LAS f32x4*)(wu + (i * 512 + tid) * 4) = t[i];
            __syncthreads();
            if (F.wave == 0) {
#pragma unroll 8
                for (int c = 0; c < 128; ++c) { const float wr_ = wu[c * 128 + lane], wi_ = wu[c * 128 + 64 + lane];
                    xs[c * 128 + lane] = (bf16_t)f2bf(cr); xs[c * 128 + 64 + lane] = (bf16_t)f2bf(ci);
                    const float nr = ar * cr - ai * ci + wr_, ni = ar * ci + ai * cr + wi_; cr = nr; ci = ni; }
            }
            __syncthreads();
#pragma unroll
            for (int i = 0; i < 4; ++i) *(u32x4*)(XC + (size_t)blk * 16384 + (size_t)(i * 512 + tid) * 8) = *(const LAS u32x4*)(xs + (i * 512 + tid) * 8);
        }
    }
    __threadfence(); __syncthreads();
    LAS bf16_t* As = (LAS bf16_t*)F.lds;
    bf16x8 bfr[2][12];
#pragma unroll
    for (int t2 = 0; t2 < 2; ++t2)
#pragma unroll
        for (int ks = 0; ks < 12; ++ks) bfr[t2][ks] = *(const bf16x8*)(KT + (size_t)((F.wave * 2 + t2) * 16 + fr) * 384 + ks * 32 + fq * 8);
    u32x4 pu, px; px = (u32x4){0u, 0u, 0u, 0u};
    pu = *(const u32x4*)(UG + (size_t)tid * 8); if (tid < 256) px = *(const u32x4*)(XC + (size_t)tid * 8);
    *(LAS u32x4*)(As + (tid >> 5) * 392 + (tid & 31) * 8) = pu; if (tid < 256) *(LAS u32x4*)(As + (tid >> 4) * 392 + 256 + (tid & 15) * 8) = px;
    __syncthreads();
    for (int mt = 0; mt < 64; ++mt) {
        const int c0 = mt * 16, buf = mt & 1;
        if (mt + 1 < 64) { pu = *(const u32x4*)(UG + (size_t)(c0 + 16) * 256 + (size_t)tid * 8); if (tid < 256) px = *(const u32x4*)(XC + (size_t)(c0 + 16) * 128 + (size_t)tid * 8); }
        bf16x8 a[12];
#pragma unroll
        for (int ks = 0; ks < 12; ++ks) a[ks] = *(const LAS bf16x8*)(As + buf * 6272 + fr * 392 + ks * 32 + fq * 8);
#pragma unroll
        for (int t2 = 0; t2 < 2; ++t2) {
            f32x4 acc = (f32x4){0.f, 0.f, 0.f, 0.f};
#pragma unroll
            for (int ks = 0; ks < 12; ++ks) acc = mfma16(bfr[t2][ks], a[ks], acc);
            const int t = F.wave * 2 + t2;
            u32x2 w; w.x = pk2(gelu_tanh(acc[0]), gelu_tanh(acc[1])); w.y = pk2(gelu_tanh(acc[2]), gelu_tanh(acc[3]));
            *(u32x2*)(YG + (size_t)((c0 + fr) * 16 + t) * 1024 + g * 16 + fq * 4) = w;
        }
        if (mt + 1 < 64) { *(LAS u32x4*)(As + (buf ^ 1) * 6272 + (tid >> 5) * 392 + (tid & 31) * 8) = pu; if (tid < 256) *(LAS u32x4*)(As + (buf ^ 1) * 6272 + (tid >> 4) * 392 + 256 + (tid & 15) * 8) = px; }
        __syncthreads();
    }
}

__device__ __forceinline__ void gdn_local_unit(const Ctx& F, int hv, int n) {
    const Params& P = *F.p;
    LAS unsigned char* lds = F.lds;
    LAS float* tmp = (LAS float*)lds;
    LAS float* Lf = (LAS float*)lds;
    LAS bf16_t* Tb = (LAS bf16_t*)(lds + 16384);
    LAS bf16_t* At = (LAS bf16_t*)(lds + 25600);
    LAS bf16_t* wT = (LAS bf16_t*)(lds + 34816);
    LAS bf16_t* uT = (LAS bf16_t*)(lds + 53248);
    LAS bf16_t* qn = (LAS bf16_t*)(lds + 71680);
    LAS bf16_t* kn = (LAS bf16_t*)(lds + 89088);
    LAS bf16_t* vbT = (LAS bf16_t*)(lds + 106496);
    LAS bf16_t* kbgT = (LAS bf16_t*)(lds + 124928);
    LAS bf16_t* kdT = (LAS bf16_t*)(lds + 143360);
    LAS float* gcs = (LAS float*)(lds + 161792);
    LAS float* bts = gcs + 64;
    const int tid = F.tid, lane = F.lane, w = F.wave, fr = lane & 15, fq = lane >> 4;
    const int hq = hv >> 1, t0 = n * 64, u = hv * 256 + n;
    const bf16_t* Y0 = WSP(bf16_t, WS_BIG + B_Y); const float* AB = WSP(float, WS_SMALL + SM_AB);
    if (tid < 64) {
        const float av = AB[(size_t)(t0 + tid) * 16 + hv], bv = AB[(size_t)(t0 + tid) * 16 + 8 + hv];
        const float xx = av + P.in[21][hv]; const float sp = (xx > 20.f) ? xx : log1pf(expf(xx));
        float gv = -expf(P.in[20][hv]) * sp;
#pragma unroll
        for (int o = 1; o < 64; o <<= 1) { const float t = __shfl_up(gv, o); if (lane >= o) gv += t; }
        gcs[tid] = gv; bts[tid] = sigmoidf_(bv);
        if (tid == 63) WSP(float, WS_SMALL + SM_GG)[u] = expf(gv);
    }
    LBAR();
    if (tid < 384) {
        const int which = tid >> 7, d = tid & 127;
        const int col = (which == 0) ? (1024 + hq * 128 + d) : (which == 1) ? (1536 + hq * 128 + d) : (2048 + hv * 128 + d);
        const int ch = (which == 0) ? (hq * 128 + d) : (which == 1) ? (512 + hq * 128 + d) : (1024 + hv * 128 + d);
        const float* cw = P.in[19]; const float w0 = cw[ch], w1 = cw[2048 + ch], w2 = cw[4096 + ch], w3 = cw[6144 + ch];
        const bf16_t* src = Y0 + col;
        unsigned short xin[67];
#pragma unroll
        for (int i = 0; i < 67; ++i) { const int tt = t0 - 3 + i; const unsigned short xv = src[(size_t)(tt < 0 ? 0 : tt) * 4096]; xin[i] = (tt >= 0) ? xv : (unsigned short)0; }
#pragma unroll
        for (int t = 0; t < 64; ++t) {
            float y = w0 * bf2f(xin[t]) + w1 * bf2f(xin[t + 1]) + w2 * bf2f(xin[t + 2]) + w3 * bf2f(xin[t + 3]); y = siluf_(y);
            if (which < 2) tmp[(which * 64 + t) * 129 + d] = y; else vbT[d * 72 + t] = (bf16_t)f2bf(y * bts[t]);
        }
    }
    LBAR();
    {
        const int which = w >> 2; const float gl = gcs[63];
        for (int rr = 0; rr < 16; ++rr) {
            const int t = (w & 3) * 16 + rr; const float a = tmp[(which * 64 + t) * 129 + lane], b = tmp[(which * 64 + t) * 129 + lane + 64];
            const float ss = wave_sum(a * a + b * b); float rinv = rsqrtf(ss + EPS);
            if (which == 0) { rinv *= 0.08838834764831845f; qn[t * 136 + lane] = (bf16_t)f2bf(a * rinv); qn[t * 136 + lane + 64] = (bf16_t)f2bf(b * rinv); }
            else { const float ka = a * rinv, kb = b * rinv, gt = gcs[t]; const float e1 = bts[t] * __expf(gt), e2 = __expf(gl - gt);
                kn[t * 136 + lane] = (bf16_t)f2bf(ka); kn[t * 136 + lane + 64] = (bf16_t)f2bf(kb);
                kbgT[lane * 72 + t] = (bf16_t)f2bf(ka * e1); kbgT[(lane + 64) * 72 + t] = (bf16_t)f2bf(kb * e1);
                kdT[lane * 72 + t] = (bf16_t)f2bf(ka * e2); kdT[(lane + 64) * 72 + t] = (bf16_t)f2bf(kb * e2); }
        }
    }
    LBAR();
    {
        const int which = w >> 2, mt = w & 3;
        for (int nt = 0; nt < 4; ++nt) {
            const f32x4 acc = tile_mm<false>(which ? qn : kn, 136, kn, 136, mt * 16, nt * 16, 4, fr, fq);
#pragma unroll
            for (int r = 0; r < 4; ++r) { const int i = mt * 16 + fq * 4 + r, j = nt * 16 + fr;
                const float dec = (i >= j) ? __expf(gcs[i] - gcs[j]) : 0.f;
                if (which == 0) Lf[i * 64 + j] = (i > j) ? bts[i] * acc[r] * dec : 0.f;
                else At[i * 72 + j] = (bf16_t)f2bf((i >= j) ? acc[r] * dec : 0.f); }
        }
    }
    LBAR();
    if (w == 0) {
        LAS float* Tf = (LAS float*)(lds + 34816);
        LAS float* Xs = (LAS float*)(lds + 51200);
        {
            const int b = lane >> 4, c = lane & 15; float t[16];
#pragma unroll
            for (int i = 0; i < 16; ++i) {
                float acc = (i == c) ? 1.f : 0.f;
#pragma unroll
                for (int j = 0; j < i; ++j) acc -= Lf[(16 * b + i) * 64 + 16 * b + j] * t[j];
                t[i] = acc;
            }
#pragma unroll
            for (int i = 0; i < 16; ++i) Tf[(16 * b + i) * 64 + 16 * b + c] = t[i];
        }
        const int ri = lane & 15, kk = lane >> 4;
#pragma unroll
        for (int i = 1; i < 4; ++i)
#pragma unroll
            for (int j = 0; j < i; ++j) {
                f32x4 acc = (f32x4){0.f, 0.f, 0.f, 0.f};
#pragma unroll
                for (int k = j; k < i; ++k)
#pragma unroll
                    for (int sq = 0; sq < 4; ++sq) acc = __builtin_amdgcn_mfma_f32_16x16x4f32(Lf[(16 * i + ri) * 64 + 16 * k + 4 * sq + kk], Tf[(16 * k + 4 * sq + kk) * 64 + 16 * j + ri], acc, 0, 0, 0);
#pragma unroll
                for (int r = 0; r < 4; ++r) Xs[(kk * 4 + r) * 16 + ri] = acc[r];
                f32x4 a2 = (f32x4){0.f, 0.f, 0.f, 0.f};
#pragma unroll
                for (int sq = 0; sq < 4; ++sq) a2 = __builtin_amdgcn_mfma_f32_16x16x4f32(Tf[(16 * i + ri) * 64 + 16 * i + 4 * sq + kk], Xs[(4 * sq + kk) * 16 + ri], a2, 0, 0, 0);
#pragma unroll
                for (int r = 0; r < 4; ++r) Tf[(16 * i + kk * 4 + r) * 64 + 16 * j + ri] = -a2[r];
            }
#pragma unroll 8
        for (int i = 0; i < 64; ++i) { const float v = ((i >> 4) >= (lane >> 4)) ? Tf[i * 64 + lane] : 0.f; Tb[i * 72 + lane] = (bf16_t)f2bf(v); }
    }
    LBAR();
    {
        const int which = w >> 2, mt = w & 3;
        for (int nt = 0; nt < 8; ++nt) {
            const f32x4 acc = tile_mm<false>(Tb, 72, which ? kbgT : vbT, 72, mt * 16, nt * 16, 2, fr, fq);
            u32x2 o; o.x = pk2(acc[0], acc[1]); o.y = pk2(acc[2], acc[3]);
            *(LAS u32x2*)((which ? wT : uT) + (nt * 16 + fr) * 72 + mt * 16 + fq * 4) = o;
        }
    }
    LBAR();
    {
        bf16_t* Pg = WSP(bf16_t, WS_H) + (size_t)u * 16384; bf16_t* RTg = WSP(bf16_t, WS_RAW + 64 * MiB) + (size_t)u * 16384;
        bf16_t* QEg = WSP(bf16_t, WS_BIG + B_QE) + (size_t)u * 8192; bf16_t* OUg = WSP(bf16_t, WS_BIG + B_OU) + (size_t)u * 8192;
        for (int tile = w; tile < 192; tile += 8) {
            if (tile < 64) { const int mt = tile >> 3, nt = tile & 7; const f32x4 acc = tile_mm<true>(kdT, 72, wT, 72, mt * 16, nt * 16, 2, fr, fq);
                u32x2 o; o.x = pk2(acc[0], acc[1]); o.y = pk2(acc[2], acc[3]);
                *(u32x2*)(Pg + (((mt * 4 + (nt >> 1)) * 64 + ((nt & 1) * 2 + (fq >> 1)) * 16 + fr) * 8 + (fq & 1) * 4)) = o; }
            else if (tile < 128) { const int tt = tile - 64, mt = tt >> 3, nt = tt & 7; const f32x4 acc = tile_mm<true>(uT, 72, kdT, 72, mt * 16, nt * 16, 2, fr, fq);
                u32x2 o; o.x = pk2(acc[0], acc[1]); o.y = pk2(acc[2], acc[3]); *(u32x2*)(RTg + ((mt * 8 + nt) * 64 + lane) * 4) = o; }
            else if (tile < 160) { const int tt = tile - 128, mt = tt >> 3, nt = tt & 7; const f32x4 acc = tile_mm<true>(At, 72, wT, 72, mt * 16, nt * 16, 2, fr, fq);
                const int i = mt * 16 + fr; const float eg = __expf(gcs[i]); float q[4];
#pragma unroll
                for (int r = 0; r < 4; ++r) q[r] = bf2f(qn[i * 136 + nt * 16 + fq * 4 + r]) * eg - acc[r];
                u32x2 o; o.x = pk2(q[0], q[1]); o.y = pk2(q[2], q[3]);
                *(u32x2*)(QEg + (((mt * 4 + (nt >> 1)) * 64 + ((nt & 1) * 2 + (fq >> 1)) * 16 + fr) * 8 + (fq & 1) * 4)) = o; }
            else { const int tt = tile - 160, mt = tt >> 3, nt = tt & 7; const f32x4 acc = tile_mm<true>(At, 72, uT, 72, mt * 16, nt * 16, 2, fr, fq);
                u32x2 o; o.x = pk2(acc[0], acc[1]); o.y = pk2(acc[2], acc[3]); *(u32x2*)(OUg + ((nt * 4 + mt) * 64 + lane) * 4) = o; }
        }
    }
    LBAR();
}

struct GS { bf16x8 pf[4], qf[4]; u32x2 rt, ou; float gl; };
__device__ __forceinline__ void gs_load(GS& x, const bf16_t* Pg, const bf16_t* RTg, const bf16_t* QEg, const bf16_t* OUg, const float* GG, int hv, int n, int w, int fr, int fq, int dv0) {
    const size_t u = (size_t)hv * 256 + n;
#pragma unroll
    for (int ks = 0; ks < 4; ++ks) x.pf[ks] = *(const bf16x8*)(Pg + u * 16384 + ((w * 4 + ks) * 64 + fq * 16 + fr) * 8);
    x.rt = *(const u32x2*)(RTg + u * 16384 + (((dv0 >> 4) * 8 + w) * 64 + fq * 16 + fr) * 4);
    x.gl = GG[u];
    if (w < 4) {
#pragma unroll
        for (int ks = 0; ks < 4; ++ks) x.qf[ks] = *(const bf16x8*)(QEg + u * 8192 + ((w * 4 + ks) * 64 + fq * 16 + fr) * 8);
        x.ou = *(const u32x2*)(OUg + u * 8192 + (((dv0 >> 4) * 4 + w) * 64 + fq * 16 + fr) * 4);
    }
}
__device__ __forceinline__ void gdn_scan_wg(const Ctx& F, int hv, int sl) {
    const Params& P = *F.p;
    LAS bf16_t* Sb = (LAS bf16_t*)F.lds;
    const int lane = F.lane, w = F.wave, fr = lane & 15, fq = lane >> 4, dv0 = sl * 16;
    const bf16_t* Pg = WSP(bf16_t, WS_H); const bf16_t* RTg = WSP(bf16_t, WS_RAW + 64 * MiB);
    const bf16_t* QEg = WSP(bf16_t, WS_BIG + B_QE); const bf16_t* OUg = WSP(bf16_t, WS_BIG + B_OU);
    const float* GG = WSP(float, WS_SMALL + SM_GG); bf16_t* O = WSP(bf16_t, WS_RAW);
    for (int e = F.tid; e < 2 * 16 * 136; e += 512) Sb[e] = 0;
    f32x4 s = (f32x4){0.f, 0.f, 0.f, 0.f};
    int* prog = WSP(int, WS_SMALL + SM_PROG) + hv * 64; const bool publish = (sl == 0);
    constexpr int RS = 4;
    GS ring[RS];
#pragma unroll
    for (int i = 0; i < RS - 1; ++i) gs_load(ring[i], Pg, RTg, QEg, OUg, GG, hv, i, w, fr, fq, dv0);
    asm volatile("s_waitcnt lgkmcnt(0)" ::: "memory"); __builtin_amdgcn_s_barrier(); asm volatile("" ::: "memory");
    for (int n0 = 0; n0 < 256; n0 += 4 * RS) {
#pragma unroll
        for (int j = 0; j < 4 * RS; ++j) {
            const int n = n0 + j;
            if (n < 256) {
            const int cur = n & 1;
            { const int nn = (n + RS - 1 < 256) ? n + RS - 1 : 255; gs_load(ring[(j + RS - 1) % RS], Pg, RTg, QEg, OUg, GG, hv, nn, w, fr, fq, dv0); }
            const GS& x = ring[j % RS];
            if (publish && F.tid == 0) __hip_atomic_store(prog, n, __ATOMIC_RELAXED, __HIP_MEMORY_SCOPE_AGENT);
            bf16x8 sf[4];
#pragma unroll
            for (int ks = 0; ks < 4; ++ks) sf[ks] = *(const LAS bf16x8*)(Sb + cur * 2176 + fr * 136 + ks * 32 + fq * 8);
            f32x4 pacc = (f32x4){0.f, 0.f, 0.f, 0.f};
#pragma unroll
            for (int ks = 0; ks < 4; ++ks) pacc = mfma16(x.pf[ks], sf[ks], pacc);
            if (w < 4) {
                f32x4 oacc = (f32x4){__uint_as_float(x.ou.x << 16), __uint_as_float(x.ou.x & 0xffff0000u), __uint_as_float(x.ou.y << 16), __uint_as_float(x.ou.y & 0xffff0000u)};
#pragma unroll
                for (int ks = 0; ks < 4; ++ks) oacc = mfma16(sf[ks], x.qf[ks], oacc);
                { u32x2 ob; ob.x = pk2(oacc[0], oacc[1]); ob.y = pk2(oacc[2], oacc[3]); *(u32x2*)(O + ((size_t)(hv * 8 + (dv0 >> 4)) * SEQ + (n * 64 + w * 16 + fr)) * 16 + fq * 4) = ob; }
            }
            const f32x4 rv = (f32x4){__uint_as_float(x.rt.x << 16), __uint_as_float(x.rt.x & 0xffff0000u), __uint_as_float(x.rt.y << 16), __uint_as_float(x.rt.y & 0xffff0000u)};
            s = s * x.gl + rv - pacc;
            u32x2 o; o.x = pk2(s[0], s[1]); o.y = pk2(s[2], s[3]);
            *(LAS u32x2*)(Sb + (cur ^ 1) * 2176 + fr * 136 + w * 16 + fq * 4) = o;
            asm volatile("s_waitcnt lgkmcnt(0)" ::: "memory"); __builtin_amdgcn_s_barrier(); asm volatile("" ::: "memory");
            }
        }
    }
    asm volatile("s_waitcnt vmcnt(0)" ::: "memory");
}
__device__ __forceinline__ void gdn_warm_wg(const Ctx& F, int hv, int wi) {
    const Params& P = *F.p;
    const char* Pg = (const char*)WSP(bf16_t, WS_H); const char* RTg = (const char*)WSP(bf16_t, WS_RAW + 64 * MiB);
    const char* QEg = (const char*)WSP(bf16_t, WS_BIG + B_QE); const char* OUg = (const char*)WSP(bf16_t, WS_BIG + B_OU);
    int* prog = WSP(int, WS_SMALL + SM_PROG) + hv * 64;
    unsigned sum = 0;
    for (int n = F.wave; n < 256; n += 8) {
        int spins = 0;
        while (true) { const int p = __hip_atomic_load(prog, __ATOMIC_RELAXED, __HIP_MEMORY_SCOPE_AGENT); if (p + 12 >= n || ++spins > 4000) break; __builtin_amdgcn_s_sleep(16); }
        const size_t u = (size_t)hv * 256 + n;
#pragma unroll
        for (int i = 0; i < 3; ++i) { const int li = wi * 192 + i * 64 + F.lane;
            const char* a = (li < 256) ? (Pg + u * 32768 + (size_t)li * 128) : (li < 512) ? (RTg + u * 32768 + (size_t)(li - 256) * 128) : (li < 640) ? (QEg + u * 16384 + (size_t)(li - 512) * 128) : (OUg + u * 16384 + (size_t)(li - 640) * 128);
            sum += *(const volatile unsigned*)a; }
    }
    if (sum == 0x9e3779b9u) prog[32] = (int)sum;
}
__device__ __forceinline__ void gdn_finalize(const Ctx& F) {
    const Params& P = *F.p;
    const bf16_t* O = WSP(bf16_t, WS_RAW); const bf16_t* Y0 = WSP(bf16_t, WS_BIG + B_Y); bf16_t* CAT = WSP(bf16_t, WS_CAT);
    const int gw = F.bid * 8 + F.wave, NGW = F.G * 8, lane = F.lane, d0 = (lane & 7) * 16;
    float nw[16];
#pragma unroll
    for (int i = 0; i < 16; ++i) nw[i] = P.in[22][d0 + i];
    for (int row = gw; row < SEQ; row += NGW) {
        float o[16]; const u32x4* op = (const u32x4*)(O + ((size_t)lane * SEQ + row) * 16);
        float ss = 0.f;
        { const u32x4 a = op[0], b = op[1]; const unsigned ww[8] = {a.x, a.y, a.z, a.w, b.x, b.y, b.z, b.w};
#pragma unroll
          for (int i = 0; i < 8; ++i) { o[2 * i] = __uint_as_float(ww[i] << 16); o[2 * i + 1] = __uint_as_float(ww[i] & 0xffff0000u); ss += o[2 * i] * o[2 * i] + o[2 * i + 1] * o[2 * i + 1]; } }
        ss += __shfl_xor(ss, 1); ss += __shfl_xor(ss, 2); ss += __shfl_xor(ss, 4);
        const float rstd = rsqrtf(ss * (1.0f / 128.0f) + EPS);
        const u32x4* zp = (const u32x4*)(Y0 + (size_t)row * 4096 + 3072 + lane * 16); unsigned zz[8];
        { const u32x4 a = zp[0], b = zp[1]; zz[0] = a.x; zz[1] = a.y; zz[2] = a.z; zz[3] = a.w; zz[4] = b.x; zz[5] = b.y; zz[6] = b.z; zz[7] = b.w; }
        unsigned ov[8];
#pragma unroll
        for (int i = 0; i < 8; ++i) { const float z0 = __uint_as_float(zz[i] << 16), z1 = __uint_as_float(zz[i] & 0xffff0000u);
            ov[i] = pk2(o[2 * i] * rstd * nw[2 * i] * siluf_(z0), o[2 * i + 1] * rstd * nw[2 * i + 1] * siluf_(z1)); }
        u32x4* cp = (u32x4*)(CAT + (size_t)row * 2048 + 1024 + lane * 16);
        cp[0] = (u32x4){ov[0], ov[1], ov[2], ov[3]}; cp[1] = (u32x4){ov[4], ov[5], ov[6], ov[7]};
    }
}

__device__ __forceinline__ void gla_local_unit(const Ctx& F, int h, int n) {
    const Params& P = *F.p;
    LAS float* bc = (LAS float*)F.lds;
    LAS bf16_t* qt = (LAS bf16_t*)(F.lds + 65536);
    LAS bf16_t* kt = (LAS bf16_t*)(F.lds + 99328);
    LAS float* gl = (LAS float*)(F.lds + 133120);
    const int tid = F.tid, lane = F.lane, w = F.wave, fr = lane & 15, fq = lane >> 4, t0 = n * 64, u = h * 256 + n;
    const bf16_t* Y1 = WSP(bf16_t, WS_BIG + B_Y); const float* GLOW = WSP(float, WS_SMALL + SM_GLOW);
    bf16_t* QT = WSP(bf16_t, WS_H) + (size_t)u * 16384; bf16_t* KDT = WSP(bf16_t, WS_H + 32 * MiB) + (size_t)u * 16384;
    bf16_t* ATT = WSP(bf16_t, WS_BIG + B_ATT) + (size_t)u * 4096; bf16_t* VT = WSP(bf16_t, WS_BIG + B_VT) + (size_t)u * 32768;
    float* GLAST = WSP(float, WS_SMALL + SM_GLAST);
    for (int e = tid; e < 1024; e += 512) gl[e] = GLOW[(size_t)t0 * 16 + e];
    LBAR();
    if (tid < 256) {
        const int dk = tid, col = h * 256 + dk; float w2[16];
#pragma unroll
        for (int j = 0; j < 16; ++j) w2[j] = P.in[34][j * 1024 + col];
        const float gb = P.in[35][col]; float run = 0.f;
        for (int t = 0; t < 64; ++t) { float x = gb;
#pragma unroll
            for (int j = 0; j < 16; ++j) x += gl[t * 16 + j] * w2[j];
            const float ls = fminf(x, 0.f) - __logf(1.0f + __expf(-fabsf(x)));
            run += ls * 0.0625f; bc[t * 256 + dk] = run; }
    } else {
        for (int rep = 0; rep < 2; ++rep) { const int dv = (tid - 256) + rep * 256; const bf16_t* src = Y1 + (size_t)t0 * 6144 + 2048 + h * 512 + dv;
            unsigned short x[64];
#pragma unroll
            for (int j = 0; j < 64; ++j) x[j] = src[(size_t)j * 6144];
#pragma unroll
            for (int c0 = 0; c0 < 64; c0 += 8) {
                u32x4 o; o.x = x[c0] | ((unsigned)x[c0 + 1] << 16); o.y = x[c0 + 2] | ((unsigned)x[c0 + 3] << 16); o.z = x[c0 + 4] | ((unsigned)x[c0 + 5] << 16); o.w = x[c0 + 6] | ((unsigned)x[c0 + 7] << 16);
                *(u32x4*)(VT + ((((dv >> 4) * 2 + (c0 >> 5)) * 64 + ((c0 >> 3) & 3) * 16 + (dv & 15)) * 8)) = o; } }
    }
    LBAR();
    for (int item = tid; item < 2048; item += 512) {
        const int dk = item & 255, tb = item >> 8; const float bl = bc[63 * 256 + dk]; float kd[8]; unsigned short qr[8], kr[8];
#pragma unroll
        for (int j = 0; j < 8; ++j) { const int t = tb * 8 + j; qr[j] = Y1[(size_t)(t0 + t) * 6144 + h * 256 + dk]; kr[j] = Y1[(size_t)(t0 + t) * 6144 + 1024 + h * 256 + dk]; }
#pragma unroll
        for (int j = 0; j < 8; ++j) { const int t = tb * 8 + j; const float b = bc[t * 256 + dk];
            const float q = bf2f(qr[j]) * 0.0625f, k = bf2f(kr[j]);
            qt[t * 264 + dk] = (bf16_t)f2bf(q * __expf(b));
            kt[t * 264 + dk] = (bf16_t)f2bf(k * __expf(-b)); kd[j] = k * __expf(bl - b); }
        u32x4 o; o.x = pk2(kd[0], kd[1]); o.y = pk2(kd[2], kd[3]); o.z = pk2(kd[4], kd[5]); o.w = pk2(kd[6], kd[7]);
        *(u32x4*)(KDT + ((((dk >> 4) * 2 + (tb >> 2)) * 64 + (tb & 3) * 16 + (dk & 15)) * 8)) = o;
        if (tb == 7) GLAST[(size_t)n * 1024 + h * 256 + dk] = __expf(bl);
    }
    LBAR();
    for (int t2 = 0; t2 < 2; ++t2) { const int tile = w * 2 + t2, mt = tile >> 2, nt = tile & 3;
        const f32x4 acc = tile_mm<true>(qt, 264, kt, 264, mt * 16, nt * 16, 8, fr, fq);
        const int i = mt * 16 + fr; float a[4];
#pragma unroll
        for (int r = 0; r < 4; ++r) { const int j = nt * 16 + fq * 4 + r; a[r] = (j <= i) ? acc[r] : 0.f; }
        u32x2 o; o.x = pk2(a[0], a[1]); o.y = pk2(a[2], a[3]); *(u32x2*)(ATT + (((mt * 2 + (nt >> 1)) * 64 + ((nt & 1) * 2 + (fq >> 1)) * 16 + fr) * 8 + (fq & 1) * 4)) = o; }
    for (int piece = tid; piece < 2048; piece += 512) { const int w_ = piece >> 8, mt = (piece >> 6) & 3, ln = piece & 63, fr_ = ln & 15, fq_ = ln >> 4;
        const LAS bf16_t* qp = qt + (mt * 16 + fr_) * 264 + w_ * 32 + fq_ * 4; const u32x2 lo = *(const LAS u32x2*)qp, hi = *(const LAS u32x2*)(qp + 16);
        *(u32x4*)(QT + (size_t)piece * 8) = (u32x4){lo.x, lo.y, hi.x, hi.y}; }
    LBAR();
}
struct LS { bf16x8 qf[4], kf[2][2], vf[2], af[2]; f32x4 g0, g1; };
__device__ __forceinline__ void ls_load(LS& x, const bf16_t* QT, const bf16_t* KDTb, const bf16_t* ATTb, const bf16_t* VTb, const float* GLAST, int h, int n, int w, int fr, int fq, int dv0, int dk0) {
    const size_t u = (size_t)h * 256 + n; const int lane = fq * 16 + fr;
#pragma unroll
    for (int mt = 0; mt < 4; ++mt) x.qf[mt] = *(const bf16x8*)(QT + u * 16384 + ((w * 4 + mt) * 64 + lane) * 8);
#pragma unroll
    for (int tl = 0; tl < 2; ++tl)
#pragma unroll
        for (int ks = 0; ks < 2; ++ks) x.kf[tl][ks] = *(const bf16x8*)(KDTb + u * 16384 + (((2 * w + tl) * 2 + ks) * 64 + lane) * 8);
#pragma unroll
    for (int ks = 0; ks < 2; ++ks) x.vf[ks] = *(const bf16x8*)(VTb + u * 32768 + (((dv0 >> 4) * 2 + ks) * 64 + lane) * 8);
    x.g0 = *(const f32x4*)(GLAST + (size_t)n * 1024 + h * 256 + dk0 + fq * 4); x.g1 = *(const f32x4*)(GLAST + (size_t)n * 1024 + h * 256 + dk0 + 16 + fq * 4);
    if (w < 4) {
#pragma unroll
        for (int ks = 0; ks < 2; ++ks) x.af[ks] = *(const bf16x8*)(ATTb + u * 4096 + ((w * 2 + ks) * 64 + lane) * 8);
    }
}
__device__ __forceinline__ void gla_scan_wg(const Ctx& F, int h, int sl) {
    const Params& P = *F.p;
    LAS float* OP = (LAS float*)F.lds;
    const int tid = F.tid, lane = F.lane, w = F.wave, fr = lane & 15, fq = lane >> 4, dv0 = sl * 16, dk0 = w * 32;
    const bf16_t* QT = WSP(bf16_t, WS_H); const bf16_t* KDTb = WSP(bf16_t, WS_H + 32 * MiB);
    const bf16_t* ATTb = WSP(bf16_t, WS_BIG + B_ATT); const bf16_t* VTb = WSP(bf16_t, WS_BIG + B_VT);
    const float* GLAST = WSP(float, WS_SMALL + SM_GLAST); bf16_t* O = WSP(bf16_t, WS_RAW);
    f32x4 s0 = (f32x4){0.f, 0.f, 0.f, 0.f}, s1 = s0;
    int* prog = WSP(int, WS_SMALL + SM_PROG) + (8 + (F.bid & 7)) * 64; const bool publish = (sl < 2);
    LS ring[3];
    ls_load(ring[0], QT, KDTb, ATTb, VTb, GLAST, h, 0, w, fr, fq, dv0, dk0);
    ls_load(ring[1], QT, KDTb, ATTb, VTb, GLAST, h, 1, w, fr, fq, dv0, dk0);
    for (int n0 = 0; n0 < 256; n0 += 12) {
#pragma unroll
        for (int j = 0; j < 12; ++j) {
            const int n = n0 + j;
            if (n < 256) {
                const int t0 = n * 64, buf = n & 1;
                { const int nn = (n + 2 < 256) ? n + 2 : 255; ls_load(ring[(j + 2) % 3], QT, KDTb, ATTb, VTb, GLAST, h, nn, w, fr, fq, dv0, dk0); }
                const LS& x = ring[j % 3];
                if (publish && tid == 0) __hip_atomic_store(prog, n, __ATOMIC_RELAXED, __HIP_MEMORY_SCOPE_AGENT);
                u32x4 sp; sp.x = pk2(s0[0], s0[1]); sp.y = pk2(s0[2], s0[3]); sp.z = pk2(s1[0], s1[1]); sp.w = pk2(s1[2], s1[3]);
                const bf16x8 sf = __builtin_bit_cast(bf16x8, sp);
                f32x4 op[4];
#pragma unroll
                for (int mt = 0; mt < 4; ++mt) op[mt] = mfma16(sf, x.qf[mt], (f32x4){0.f, 0.f, 0.f, 0.f});
                if (w < 4) {
                    f32x4 oi = (f32x4){0.f, 0.f, 0.f, 0.f};
#pragma unroll
                    for (int ks = 0; ks < 2; ++ks) oi = mfma16(x.vf[ks], x.af[ks], oi);
#pragma unroll
                    for (int mt = 0; mt < 4; ++mt) if (mt == w) op[mt] += oi;
                }
#pragma unroll
                for (int mt = 0; mt < 4; ++mt) *(LAS f32x4*)(OP + ((buf * 8 + w) * 64 + mt * 16 + fr) * 16 + fq * 4) = op[mt];
                f32x4 u0 = (f32x4){0.f, 0.f, 0.f, 0.f}, u1 = u0;
#pragma unroll
                for (int ks = 0; ks < 2; ++ks) { u0 = mfma16(x.kf[0][ks], x.vf[ks], u0); u1 = mfma16(x.kf[1][ks], x.vf[ks], u1); }
                s0 = s0 * x.g0 + u0; s1 = s1 * x.g1 + u1;
                asm volatile("s_waitcnt lgkmcnt(0)" ::: "memory"); __builtin_amdgcn_s_barrier(); asm volatile("" ::: "memory");
                { const int e = tid * 2; float a = 0.f, b = 0.f;
#pragma unroll
                    for (int ww = 0; ww < 8; ++ww) { const f32x2 xx = *(const LAS f32x2*)(OP + (buf * 8 + ww) * 1024 + e); a += xx[0]; b += xx[1]; }
                    *(unsigned*)(O + ((size_t)(h * 32 + (dv0 >> 4)) * SEQ + t0) * 16 + e) = pk2(a, b); }
            }
        }
    }
    asm volatile("s_waitcnt vmcnt(0)" ::: "memory");
}
__device__ __forceinline__ void gla_warm_wg(const Ctx& F, int xcd, int wi) {
    const Params& P = *F.p;
    const int h = xcd & 3;
    const char* QT = (const char*)WSP(bf16_t, WS_H); const char* KDTb = (const char*)WSP(bf16_t, WS_H + 32 * MiB);
    const char* ATTb = (const char*)WSP(bf16_t, WS_BIG + B_ATT); const char* VTb = (const char*)WSP(bf16_t, WS_BIG + B_VT);
    int* prog = WSP(int, WS_SMALL + SM_PROG) + (8 + xcd) * 64;
    unsigned sum = 0;
    for (int n = F.wave; n < 256; n += 8) {
        int spins = 0;
        while (true) { const int p = __hip_atomic_load(prog, __ATOMIC_RELAXED, __HIP_MEMORY_SCOPE_AGENT); if (p + 12 >= n || ++spins > 4000) break; __builtin_amdgcn_s_sleep(16); }
        const size_t u = (size_t)h * 256 + n;
#pragma unroll
        for (int i = 0; i < 5; ++i) { const int li = wi * 272 + i * 64 + F.lane;
            if (i * 64 + F.lane < 272) {
                const char* a = (li < 256) ? (QT + u * 32768 + (size_t)li * 128) : (li < 512) ? (KDTb + u * 32768 + (size_t)(li - 256) * 128) : (li < 576) ? (ATTb + u * 8192 + (size_t)(li - 512) * 128) : (VTb + u * 65536 + (size_t)(li - 576) * 128);
                sum += *(const volatile unsigned*)a; } }
    }
    if (sum == 0x9e3779b9u) prog[32] = (int)sum;
}
__device__ __forceinline__ void gla_finalize(const Ctx& F) {
    const Params& P = *F.p;
    const bf16_t* O = WSP(bf16_t, WS_RAW); const bf16_t* Y1 = WSP(bf16_t, WS_BIG + B_Y); bf16_t* CAT = WSP(bf16_t, WS_CAT);
    const int gw = F.bid * 8 + F.wave, NGW = F.G * 8, lane = F.lane, d0 = (lane & 15) * 32;
    for (int row = gw; row < SEQ; row += NGW) {
        f32x4 o[8]; const u32x4* op0 = (const u32x4*)(O + ((size_t)(lane * 2) * SEQ + row) * 16); const u32x4* op1 = (const u32x4*)(O + ((size_t)(lane * 2 + 1) * SEQ + row) * 16); float ss = 0.f;
        const u32x4 ob[4] = {op0[0], op0[1], op1[0], op1[1]};
#pragma unroll
        for (int i = 0; i < 8; ++i) { const u32x4 q4 = ob[i >> 1]; const unsigned w0 = (i & 1) ? q4.z : q4.x, w1 = (i & 1) ? q4.w : q4.y;
            o[i] = (f32x4){__uint_as_float(w0 << 16), __uint_as_float(w0 & 0xffff0000u), __uint_as_float(w1 << 16), __uint_as_float(w1 & 0xffff0000u)}; ss += (o[i][0] * o[i][0] + o[i][1] * o[i][1]) + (o[i][2] * o[i][2] + o[i][3] * o[i][3]); }
        ss += __shfl_xor(ss, 1); ss += __shfl_xor(ss, 2); ss += __shfl_xor(ss, 4); ss += __shfl_xor(ss, 8);
        const float rstd = rsqrtf(ss * (1.0f / 512.0f) + EPS);
        const u32x4* rp = (const u32x4*)(Y1 + (size_t)row * 6144 + 4096 + lane * 32); u32x4* cp = (u32x4*)(CAT + (size_t)row * 2048 + lane * 32);
#pragma unroll
        for (int i = 0; i < 4; ++i) { const u32x4 rv = rp[i]; const unsigned rr[4] = {rv.x, rv.y, rv.z, rv.w}; unsigned ov[4];
#pragma unroll
            for (int j = 0; j < 4; ++j) { const int e = i * 8 + j * 2; const float r0 = __uint_as_float(rr[j] << 16), r1 = __uint_as_float(rr[j] & 0xffff0000u);
                const float x0 = o[e >> 2][e & 3], x1 = o[(e + 1) >> 2][(e + 1) & 3];
                ov[j] = pk2(x0 * rstd * P.in[36][d0 + e] * siluf_(r0), x1 * rstd * P.in[36][d0 + e + 1] * siluf_(r1)); }
            cp[i] = (u32x4){ov[0], ov[1], ov[2], ov[3]}; }
    }
}

#define XB_TMO      128
#define XB_XCNT(j)  (256  + 64 * (j))
#define XB_XSUB(j)  (1280 + 64 * (j))
#define XB_XGEN(j)  (2304 + 64 * (j))
#define XB_TOP      3328
#define XB_TOPGEN   3392
#define XCD_BAR_WORDS 3456
#define XB_SPIN_CAP (1u << 18)
__device__ __forceinline__ unsigned xb_ld(unsigned* p)              { return __hip_atomic_load(p, __ATOMIC_RELAXED, __HIP_MEMORY_SCOPE_AGENT); }
__device__ __forceinline__ unsigned xb_add(unsigned* p, unsigned v) { return __hip_atomic_fetch_add(p, v, __ATOMIC_RELAXED, __HIP_MEMORY_SCOPE_AGENT); }
__device__ __forceinline__ unsigned xb_xcc_id() { return (unsigned)__builtin_amdgcn_s_getreg((3 << 11) | 20) & 0xFu; }
#define XB_SPIN(cond, bar) do { unsigned _sp = 0; while (cond) { __builtin_amdgcn_s_sleep(1); \
    if ((++_sp & 255u) == 0u) { if (xb_ld(&(bar)[XB_TMO])) break; if (_sp > XB_SPIN_CAP) { atomicAdd(&(bar)[XB_TMO], 1u); break; } } } } while (0)
struct XcdBarrier { unsigned* bar; unsigned x; volatile LAS unsigned* st; };
__device__ __forceinline__ XcdBarrier xcd_barrier_post(unsigned* bar, volatile LAS unsigned* st) {
    XcdBarrier b; b.bar = bar; b.x = xb_xcc_id(); b.st = st;
    if (threadIdx.x == 0) (void)xb_add(&bar[XB_XCNT(b.x)], 1u);
    return b;
}
__device__ __forceinline__ void xcd_barrier_complete(unsigned* bar, unsigned x, unsigned& nloc, unsigned& nx) {
    const unsigned G = gridDim.x * gridDim.y * gridDim.z;
    unsigned sum, cnt, mine, sp = 0u;
    for (;;) {
        sum = 0u; cnt = 0u; mine = 0u;
#pragma unroll
        for (unsigned j = 0; j < 16; ++j) { const unsigned c = xb_ld(&bar[XB_XCNT(j)]); sum += c; cnt += (c > 0u) ? 1u : 0u; mine = (j == x) ? c : mine; }
        if (sum == G) break;
        __builtin_amdgcn_s_sleep(1);
        if ((++sp & 255u) == 0u) { if (xb_ld(&bar[XB_TMO])) break; if (sp > XB_SPIN_CAP) { atomicAdd(&bar[XB_TMO], 1u); break; } }
    }
    nloc = mine > 0u ? mine : 1u; nx = cnt > 0u ? cnt : 1u;
}
__device__ __forceinline__ void xcd_barrier(const XcdBarrier& b) {
    asm volatile("s_waitcnt vmcnt(0)" ::: "memory");
    __syncthreads();
    if (threadIdx.x == 0) {
        unsigned* bar = b.bar;
        __builtin_amdgcn_s_waitcnt(0);
        unsigned nloc = b.st[0], nx = b.st[1];
        if (nloc == 0u) { xcd_barrier_complete(bar, b.x, nloc, nx); b.st[0] = nloc; b.st[1] = nx; }
        const unsigned old = xb_add(&bar[XB_XSUB(b.x)], 1u);
        const unsigned gen = old / nloc;
        if (old + 1u == (gen + 1u) * nloc) {
            __builtin_amdgcn_fence(__ATOMIC_RELEASE, "agent");
            asm volatile("s_waitcnt vmcnt(0)" ::: "memory");
            const unsigned og = xb_add(&bar[XB_TOP], 1u);
            const unsigned tg = og / nx;
            if (og + 1u == (tg + 1u) * nx) xb_add(&bar[XB_TOPGEN], 1u);
            else XB_SPIN(xb_ld(&bar[XB_TOPGEN]) == tg, bar);
            __builtin_amdgcn_fence(__ATOMIC_ACQUIRE, "agent");
            xb_add(&bar[XB_XGEN(b.x)], 1u);
            asm volatile("s_waitcnt vmcnt(0)" ::: "memory");
        } else {
            XB_SPIN(xb_ld(&bar[XB_XGEN(b.x)]) == gen, bar);
            __builtin_amdgcn_fence(__ATOMIC_ACQUIRE, "agent");
            asm volatile("s_waitcnt vmcnt(0)" ::: "memory");
        }
    }
    __syncthreads();
}

__global__ void __launch_bounds__(512, 2) fwd_megakernel(Params prm) {
    extern __shared__ __attribute__((aligned(16))) unsigned char lds_raw[];
    Ctx F; F.lds = (LAS unsigned char*)lds_raw; F.tid = threadIdx.x; F.lane = F.tid & 63; F.wave = __builtin_amdgcn_readfirstlane(F.tid >> 6); F.G = gridDim.x; F.bid = blockIdx.x; F.p = &prm;
    const Params& P = prm;
    const int lo = P.ph_lo, hi = P.ph_hi;
    volatile LAS unsigned* xst = (volatile LAS unsigned*)(F.lds + (LDS_BYTES - 16));
    XcdBarrier xb; xb.bar = WSP(unsigned, WS_SMALL + SM_XBAR); xb.x = 0; xb.st = xst;
    if (hi - lo > 1) { if (F.tid < 4) xst[F.tid] = 0u; __syncthreads(); xb = xcd_barrier_post(WSP(unsigned, WS_SMALL + SM_XBAR), xst); }
    if (hi > 1000) cg::this_grid().sync();
    bf16_t* Wb = WSP(bf16_t, WS_W);
#define WPTR(off) ((const bf16_t*)((const char*)Wb + (off)))
#define PHASE(k) if (lo <= (k) && (k) < hi)
#define SEAM(k) if (lo <= (k) && (k) + 1 < hi) { xcd_barrier(xb); }
    PHASE(0) { phase_prologue(F); } SEAM(0)
    PHASE(1) { RowCfg c{0, 0, 0, 0, 4, 2048, 0, 8, 4112, 4096, P.in[0], WSP(float, WS_SMALL + SM_AB)}; row_phase<false, true, true>(F, c); } SEAM(1)
    PHASE(2) { pg8::Gemm g{WSP(bf16_t, WS_H), WPTR(W_IN0), SEQ, 4096, 2048}; pg8::StaticOrder S; S.init(SEQ, 4096, F.G, F.bid); pg8::EpiIn0 E{WSP(bf16_t, WS_BIG + B_Y), 4096, WSP(bf16_t, WS_BIG + B_UG)}; pg8::gemm_phase(F.lds, g, S, E); } SEAM(2)
    PHASE(3) { if (F.bid == 0 && F.tid < 8) WSP(int, WS_SMALL + SM_PROG)[F.tid * 64] = 0; for (int un = F.bid; un < 2048; un += F.G) gdn_local_unit(F, un & 7, un >> 3); s5_wu_phase(F); } SEAM(3)
    PHASE(4) { if (F.bid < 64) { if (P.mode4 != 2) gdn_scan_wg(F, F.bid & 7, F.bid >> 3); } else if (F.bid < 128) { if (P.mode4 != 1) s5_group_phase(F, F.bid - 64); } else if (F.bid < 224) { if (P.mode4 != 2) ada_gemv_layer1_idle(F, 128, 224); } else gdn_warm_wg(F, F.bid & 7, (F.bid - 224) >> 3); } SEAM(4)
    PHASE(5) { pg8::Gemm g{WSP(bf16_t, WS_BIG + B_YG), WPTR(W_GLU), SEQ, 1024, 1024}; pg8::StaticOrder S; S.init(SEQ, 1024, F.G, F.bid);
               pg8::EpiGlu E{WSP(bf16_t, WS_CAT), 2048, WSP(bf16_t, WS_BIG + B_YG), 1024, P.in[18]}; pg8::gemm_phase(F.lds, g, S, E); gdn_finalize(F); } SEAM(5)
    PHASE(6) { pg8::Gemm g{WSP(bf16_t, WS_CAT), WPTR(W_OUT0), SEQ, 2048, 2048}; pg8::StaticOrder S; S.init(SEQ, 2048, F.G, F.bid); pg8::EpiRaw E{WSP(bf16_t, WS_RAW), 2048, WSP(float, WS_SMALL + SM_SSQ)}; pg8::gemm_phase(F.lds, g, S, E); } SEAM(6)
    PHASE(7) { RowCfg c{0, 4096, 5, 0, 6, 8192, 6144, 0, 0, 0, P.in[0], nullptr}; row_phase<true, true, false>(F, c); } SEAM(7)
    PHASE(8) { pg8::Gemm g{WSP(bf16_t, WS_H), WPTR(W_GU0), SEQ, 11264, 2048}; pg8::StaticOrder S; S.init(SEQ, 11264, F.G, F.bid); pg8::EpiSwiglu E{WSP(bf16_t, WS_BIG + B_HID), FFH}; pg8::gemm_phase(F.lds, g, S, E); } SEAM(8)
    PHASE(9) { pg8::Gemm g{WSP(bf16_t, WS_BIG + B_HID), WPTR(W_DN0), SEQ, 2048, FFH}; pg8::StaticOrder S; S.init(SEQ, 2048, F.G, F.bid); pg8::EpiRaw E{WSP(bf16_t, WS_RAW), 2048, WSP(float, WS_SMALL + SM_SSQ)}; pg8::gemm_phase(F.lds, g, S, E); } SEAM(9)
    PHASE(10) { RowCfg c{0, 10240, 7, 1, 29, 2048, 0, 33, 6160, 6144, P.out, WSP(float, WS_SMALL + SM_GLOW)};
                row_phase<true, true, true>(F, c); } SEAM(10)
    PHASE(11) { pg8::Gemm g{WSP(bf16_t, WS_H), WPTR(W_IN1), SEQ, 6144, 2048}; pg8::StaticOrder S; S.init(SEQ, 6144, F.G, F.bid); pg8::EpiBf16Store E{WSP(bf16_t, WS_BIG + B_Y), 6144}; pg8::gemm_phase(F.lds, g, S, E); } SEAM(11)
    PHASE(12) { if (F.bid == 0 && F.tid < 8) WSP(int, WS_SMALL + SM_PROG)[(8 + F.tid) * 64] = 0; for (int un = F.bid; un < 1024; un += F.G) gla_local_unit(F, un & 3, un >> 2); } SEAM(12)
    PHASE(13) { if (F.bid < 128) gla_scan_wg(F, F.bid & 3, F.bid >> 2); else if (F.bid < 224) convert_layer1_rest_idle(F, 128, 224); else gla_warm_wg(F, F.bid & 7, (F.bid - 224) >> 3); } SEAM(13)
    PHASE(14) { gla_finalize(F); } SEAM(14)
    PHASE(15) { pg8::Gemm g{WSP(bf16_t, WS_CAT), WPTR(W_OUT1), SEQ, 2048, 2048}; pg8::StaticOrder S; S.init(SEQ, 2048, F.G, F.bid); pg8::EpiRaw E{WSP(bf16_t, WS_RAW), 2048, WSP(float, WS_SMALL + SM_SSQ)}; pg8::gemm_phase(F.lds, g, S, E); } SEAM(15)
    PHASE(16) { RowCfg c{1, 4096, 30, 1, 31, 8192, 6144, 0, 0, 0, P.out, nullptr}; row_phase<true, true, false>(F, c); } SEAM(16)
    PHASE(17) { pg8::Gemm g{WSP(bf16_t, WS_H), WPTR(W_GU1), SEQ, 11264, 2048}; pg8::StaticOrder S; S.init(SEQ, 11264, F.G, F.bid); pg8::EpiSwiglu E{WSP(bf16_t, WS_BIG + B_HID), FFH}; pg8::gemm_phase(F.lds, g, S, E); } SEAM(17)
    PHASE(18) { pg8::Gemm g{WSP(bf16_t, WS_BIG + B_HID), WPTR(W_DN1), SEQ, 2048, FFH}; pg8::StaticOrder S; S.init(SEQ, 2048, F.G, F.bid); pg8::EpiRaw E{WSP(bf16_t, WS_RAW), 2048, WSP(float, WS_SMALL + SM_SSQ)}; pg8::gemm_phase(F.lds, g, S, E); } SEAM(18)
    PHASE(19) { RowCfg c{1, 10240, 32, 1, 0, 0, 0, 0, 0, 0, P.out, nullptr}; row_phase<true, false, false>(F, c); }
}

extern "C" void kernel_launch(void* const* d_in, const int* in_sizes, int n_in, void* d_out, int out_size, void* d_ws, size_t ws_size, hipStream_t stream) {
    static int grid = 0;
    if (grid == 0) {
        if (n_in != 41 || ws_size < WS_END) { fprintf(stderr, "kernel_launch: unexpected n_in %d / ws_size %zu (need %zu)\n", n_in, ws_size, (size_t)WS_END); grid = -1; return; }
        int dev = 0, cus = 0, per_cu = 0;
        hipGetDevice(&dev); hipDeviceGetAttribute(&cus, hipDeviceAttributeMultiprocessorCount, dev);
        if (hipFuncSetAttribute((const void*)fwd_megakernel, hipFuncAttributeMaxDynamicSharedMemorySize, LDS_BYTES) != hipSuccess) { fprintf(stderr, "kernel_launch: hipFuncSetAttribute failed\n"); grid = -1; return; }
        hipOccupancyMaxActiveBlocksPerMultiprocessor(&per_cu, (const void*)fwd_megakernel, 512, LDS_BYTES);
        (void)hipGetLastError();
        if (per_cu < 1) per_cu = 1;
        grid = cus * 1;
        fprintf(stderr, "kernel_launch: cus %d per_cu %d grid %d ws %zu\n", cus, per_cu, grid, ws_size);
    }
    if (grid < 0) return;
    Params p{};
    for (int i = 0; i < 41; ++i) p.in[i] = (const float*)d_in[i];
    p.out = (float*)d_out; p.ws = (unsigned char*)d_ws;
#if MK_SINGLE_LAUNCH
    p.ph_lo = 0; p.ph_hi = NPHASE;
    (void)hipMemsetAsync((char*)d_ws + WS_SMALL + SM_XBAR, 0, 3456 * 4, stream);
    void* args[] = {&p};
    hipError_t e = hipLaunchCooperativeKernel((const void*)fwd_megakernel, dim3(grid), dim3(512), args, LDS_BYTES, stream);
    if (e != hipSuccess) fprintf(stderr, "cooperative launch failed: %s (grid %d)\n", hipGetErrorString(e), grid);
#else
    static const int HREP[NPHASE] = {1,1,1,1,1, 1,1,1,1,1, 1,1,1,1,1, 1,1,1,1,1};
    static const int M4[4] = {M4LIST};
    for (int ph = 0; ph < NPHASE; ++ph) for (int r = 0; r < HREP[ph]; ++r) {
        p.ph_lo = ph; p.ph_hi = ph + 1; p.mode4 = (ph == 4) ? M4[r] : 0;
        hipLaunchKernelGGL(fwd_megakernel, dim3(grid), dim3(512), LDS_BYTES, stream, p);
    }
#endif
}
```

```cpp
#include <hip/hip_runtime.h>
#include <hip/hip_cooperative_groups.h>
#include <cstdio>
#include <cstdint>
namespace cg = cooperative_groups;

#ifndef MK_SINGLE_LAUNCH
#define MK_SINGLE_LAUNCH 1
#define M4LIST 0,0,0,0
#endif

#define LAS __attribute__((address_space(3)))
typedef unsigned short bf16_t;
typedef short bf16x8 __attribute__((ext_vector_type(8)));
typedef float f32x4 __attribute__((ext_vector_type(4)));
typedef float f32x2 __attribute__((ext_vector_type(2)));
typedef unsigned u32x4 __attribute__((ext_vector_type(4)));
typedef unsigned u32x2 __attribute__((ext_vector_type(2)));

constexpr int SEQ = 16384, DM = 2048, FFH = 5632;
constexpr int NPHASE = 20;
constexpr float EPS = 1e-6f;
constexpr size_t MiB = 1ull << 20;
constexpr size_t WS_SMALL = 0, WS_W = 8 * MiB, WS_H = 108 * MiB, WS_RAW = 172 * MiB, WS_CAT = 300 * MiB, WS_BIG = 364 * MiB, WS_END = 684 * MiB;
constexpr size_t SM_MODP = 0;
constexpr size_t SM_AB = 1 * MiB;
constexpr size_t SM_GLOW = 2 * MiB;
constexpr size_t SM_SSQ = 3 * MiB;
constexpr size_t SM_A16 = 5 * MiB;
constexpr size_t SM_GG = 5 * MiB + 65536;
constexpr size_t SM_GLAST = 6 * MiB;
constexpr size_t SM_XBAR = 7 * MiB;
constexpr size_t SM_PROG = 5 * MiB + 131072;
constexpr size_t W_IN0 = 0, W_GLU = 24 * MiB, W_OUT0 = 26 * MiB, W_GU0 = 34 * MiB, W_DN0 = 78 * MiB;
constexpr size_t W_IN1 = 0, W_OUT1 = 24 * MiB, W_GU1 = 32 * MiB, W_DN1 = 76 * MiB;
constexpr size_t B_Y = 0;
constexpr size_t B_S5WT = 128 * MiB, B_S5KT = 132 * MiB, B_S5WU = 144 * MiB, B_S5XC = 176 * MiB;
constexpr size_t B_QE = 192 * MiB, B_OU = 224 * MiB, B_YG = 256 * MiB, B_UG = 288 * MiB;
constexpr size_t B_ATT = 192 * MiB, B_VT = 200 * MiB;
constexpr size_t B_HID = 0;
constexpr int LDS_BYTES = 163840;

struct Params { const float* in[41]; float* out; unsigned char* ws; int ph_lo, ph_hi, mode4, pad; };

__device__ __forceinline__ unsigned f2bf(float f) { unsigned u = __float_as_uint(f); return (u + 0x7fffu + ((u >> 16) & 1u)) >> 16; }
__device__ __forceinline__ float bf2f(unsigned short b) { return __uint_as_float(((unsigned)b) << 16); }
__device__ __forceinline__ unsigned pk2(float lo, float hi) { return f2bf(lo) | (f2bf(hi) << 16); }
__device__ __forceinline__ unsigned cvt_pk_bf16(float lo, float hi) { unsigned r; asm volatile("v_cvt_pk_bf16_f32 %0, %1, %2" : "=v"(r) : "v"(lo), "v"(hi)); return r; }
__device__ __forceinline__ float wave_sum(float v) {
#pragma unroll
    for (int o = 1; o < 64; o <<= 1) v += __shfl_xor(v, o);
    return v;
}
__device__ __forceinline__ float sigmoidf_(float x) { return __builtin_amdgcn_rcpf(1.0f + __expf(-x)); }
__device__ __forceinline__ float siluf_(float x) { return x * __builtin_amdgcn_rcpf(1.0f + __expf(-x)); }
#define LBAR() do { asm volatile("s_waitcnt lgkmcnt(0)" ::: "memory"); __builtin_amdgcn_s_barrier(); asm volatile("" ::: "memory"); } while (0)
__device__ __forceinline__ f32x4 mfma16(bf16x8 a, bf16x8 b, f32x4 c) { return __builtin_amdgcn_mfma_f32_16x16x32_bf16(a, b, c, 0, 0, 0); }

namespace pg8 {
constexpr int BM = 256, BK = 64, HALF = 128, HTB = HALF * BK * 2, STAGE_BYTES = 8 * HTB, NXCD = 8, WGM = 8;
__host__ __device__ __forceinline__ int lds_byte(int r, int c) { const int st = (r >> 4) * 2 + (c >> 5), rr = r & 15, cc = c & 31, ob = rr * 64 + cc * 2; return st * 1024 + (ob ^ (((ob >> 9) & 1) << 5)); }
__host__ __device__ __forceinline__ void stage_rc(int b, int& R, int& C) { const int st = b / 1024, sb = b % 1024, swz = sb ^ (((sb >> 9) & 1) << 5); R = (st >> 1) * 16 + swz / 64; C = (st & 1) * 32 + (swz % 64) / 2; }
__host__ __device__ __forceinline__ int perm32(int rho) { const int n = rho >> 4, i = rho & 15; return 8 * (i >> 2) + 4 * n + (i & 3); }
struct Unit { int pm, pn; };
struct Gemm { const bf16_t* A; const bf16_t* Bt; int M, N, K; };
struct StaticOrder {
    int nM, nN, nwg, G, c;
    __device__ __forceinline__ void init(int M, int N, int G_, int c_) { nM = M / BM; nN = N / BM; nwg = nM * nN; G = G_; c = c_; }
    __device__ bool next(int i, Unit& u) const {
        const long L = (long)i * G + c; if (L >= nwg) return false;
        int wgid = (int)L; { const int q = nwg / NXCD, r = nwg % NXCD, xcd = wgid % NXCD, off = wgid / NXCD; wgid = (xcd < r ? xcd * (q + 1) : r * (q + 1) + (xcd - r) * q) + off; }
        const int nig = WGM * nN, gid = wgid / nig, fm = gid * WGM, gsz = (nM - fm) < WGM ? (nM - fm) : WGM;
        u.pm = fm + ((wgid % nig) % gsz); u.pn = (wgid % nig) / gsz; return true;
    }
};
struct EpiBf16Store {
    static constexpr bool PERM = true;
    bf16_t* O; int ldc;
    __device__ __forceinline__ void operator()(const f32x4 (&acc)[2][2][4][2], const Unit& u, int wr, int wc, int fr, int fq) const {
        const int row0 = u.pm * BM + wr * 64 + fr, col0 = u.pn * BM + wc * 32 + 8 * fq;
#pragma unroll
        for (int ai = 0; ai < 2; ++ai)
#pragma unroll
            for (int m = 0; m < 4; ++m) { bf16_t* rowp = O + (size_t)(row0 + ai * HALF + m * 16) * ldc + col0;
#pragma unroll
                for (int bj = 0; bj < 2; ++bj) { const f32x4 v0 = acc[ai][bj][m][0], v1 = acc[ai][bj][m][1];
                    u32x4 w; w.x = cvt_pk_bf16(v0[0], v0[1]); w.y = cvt_pk_bf16(v0[2], v0[3]); w.z = cvt_pk_bf16(v1[0], v1[1]); w.w = cvt_pk_bf16(v1[2], v1[3]);
                    *(u32x4*)(rowp + bj * HALF) = w; } }
    }
};
struct EpiIn0 {
    static constexpr bool PERM = true;
    bf16_t* O; int ldc; bf16_t* UG;
    __device__ __forceinline__ void operator()(const f32x4 (&acc)[2][2][4][2], const Unit& u, int wr, int wc, int fr, int fq) const {
        const int row0 = u.pm * BM + wr * 64 + fr, col0 = u.pn * BM + wc * 32 + 8 * fq;
#pragma unroll
        for (int ai = 0; ai < 2; ++ai)
#pragma unroll
            for (int m = 0; m < 4; ++m) { const int r = row0 + ai * HALF + m * 16;
#pragma unroll
                for (int bj = 0; bj < 2; ++bj) { const f32x4 v0 = acc[ai][bj][m][0], v1 = acc[ai][bj][m][1]; const int col = col0 + bj * HALF;
                    u32x4 w; w.x = cvt_pk_bf16(v0[0], v0[1]); w.y = cvt_pk_bf16(v0[2], v0[3]); w.z = cvt_pk_bf16(v1[0], v1[1]); w.w = cvt_pk_bf16(v1[2], v1[3]);
                    bf16_t* dst = (u.pn < 4) ? (UG + ((size_t)(col >> 4) * SEQ + r) * 16 + (col & 15)) : (O + (size_t)r * ldc + col);
                    *(u32x4*)dst = w; } }
    }
};
struct EpiGlu {
    static constexpr bool PERM = true;
    bf16_t* O; int ldc; const bf16_t* Y; int ldy; const float* bias;
    __device__ __forceinline__ void operator()(const f32x4 (&acc)[2][2][4][2], const Unit& u, int wr, int wc, int fr, int fq) const {
        const int row0 = u.pm * BM + wr * 64 + fr, col0 = u.pn * BM + wc * 32 + 8 * fq;
        f32x4 bv[2][2];
#pragma unroll
        for (int bj = 0; bj < 2; ++bj)
#pragma unroll
            for (int n = 0; n < 2; ++n) bv[bj][n] = *(const f32x4*)(bias + col0 + bj * HALF + 4 * n);
#pragma unroll
        for (int ai = 0; ai < 2; ++ai)
#pragma unroll
            for (int m = 0; m < 4; ++m) { const size_t r = (size_t)(row0 + ai * HALF + m * 16);
#pragma unroll
                for (int bj = 0; bj < 2; ++bj) {
                    const u32x4 yv = *(const u32x4*)(Y + r * ldy + col0 + bj * HALF);
                    const f32x4 v0 = acc[ai][bj][m][0] + bv[bj][0], v1 = acc[ai][bj][m][1] + bv[bj][1];
                    float o[8];
                    const unsigned yy[4] = {yv.x, yv.y, yv.z, yv.w};
#pragma unroll
                    for (int j = 0; j < 4; ++j) { const float ylo = __uint_as_float(yy[j] << 16), yhi = __uint_as_float(yy[j] & 0xffff0000u);
                        const float a0 = (j < 2) ? v0[2 * j] : v1[2 * j - 4], a1 = (j < 2) ? v0[2 * j + 1] : v1[2 * j - 3];
                        o[2 * j] = ylo * sigmoidf_(a0); o[2 * j + 1] = yhi * sigmoidf_(a1); }
                    u32x4 w; w.x = cvt_pk_bf16(o[0], o[1]); w.y = cvt_pk_bf16(o[2], o[3]); w.z = cvt_pk_bf16(o[4], o[5]); w.w = cvt_pk_bf16(o[6], o[7]);
                    *(u32x4*)(O + r * ldc + col0 + bj * HALF) = w; } }
    }
};
struct EpiSwiglu {
    static constexpr bool PERM = true;
    bf16_t* O; int ldc;
    __device__ __forceinline__ void operator()(const f32x4 (&acc)[2][2][4][2], const Unit& u, int wr, int wc, int fr, int fq) const {
        const int row0 = u.pm * BM + wr * 64 + fr, col0 = u.pn * HALF + wc * 32 + 8 * fq;
#pragma unroll
        for (int ai = 0; ai < 2; ++ai)
#pragma unroll
            for (int m = 0; m < 4; ++m) { bf16_t* rowp = O + (size_t)(row0 + ai * HALF + m * 16) * ldc + col0;
                float o[8];
#pragma unroll
                for (int n = 0; n < 2; ++n)
#pragma unroll
                    for (int j = 0; j < 4; ++j) { const float g = acc[ai][0][m][n][j], up = acc[ai][1][m][n][j]; o[4 * n + j] = siluf_(g) * up; }
                u32x4 w; w.x = cvt_pk_bf16(o[0], o[1]); w.y = cvt_pk_bf16(o[2], o[3]); w.z = cvt_pk_bf16(o[4], o[5]); w.w = cvt_pk_bf16(o[6], o[7]);
                *(u32x4*)rowp = w; }
    }
};
struct EpiRaw {
    static constexpr bool PERM = true;
    bf16_t* C; int ldc; float* ssq;
    __device__ __forceinline__ void operator()(const f32x4 (&acc)[2][2][4][2], const Unit& u, int wr, int wc, int fr, int fq) const {
        const int row0 = u.pm * BM + wr * 64 + fr, col0 = u.pn * BM + wc * 32 + 8 * fq;
#pragma unroll
        for (int ai = 0; ai < 2; ++ai)
#pragma unroll
            for (int m = 0; m < 4; ++m) { const int r = row0 + ai * HALF + m * 16; bf16_t* rowp = C + (size_t)r * ldc + col0; float s = 0.f;
#pragma unroll
                for (int bj = 0; bj < 2; ++bj) { const f32x4 v0 = acc[ai][bj][m][0], v1 = acc[ai][bj][m][1];
                    s += (v0[0] * v0[0] + v0[1] * v0[1]) + (v0[2] * v0[2] + v0[3] * v0[3]) + (v1[0] * v1[0] + v1[1] * v1[1]) + (v1[2] * v1[2] + v1[3] * v1[3]);
                    u32x4 w; w.x = cvt_pk_bf16(v0[0], v0[1]); w.y = cvt_pk_bf16(v0[2], v0[3]); w.z = cvt_pk_bf16(v1[0], v1[1]); w.w = cvt_pk_bf16(v1[2], v1[3]);
                    *(u32x4*)(rowp + bj * HALF) = w; }
                s += __shfl_xor(s, 16); s += __shfl_xor(s, 32);
                if (fq == 0) ssq[(size_t)r * 32 + u.pn * 4 + wc] = s; }
    }
};

template <class Epi>
__device__ __forceinline__ void gemm_phase(LAS unsigned char* lds, const Gemm g, const StaticOrder& S, const Epi& E) {
    const int tid = threadIdx.x, wid = __builtin_amdgcn_readfirstlane(tid >> 6), lane = tid & 63, wr = wid >> 2, wc = wid & 3, fr = lane & 15, fq = lane >> 4;
    const int K = g.K, nt = K / BK;
    unsigned voffA[2], voffB[2];
#pragma unroll
    for (int i = 0; i < 2; ++i) { int R, C; stage_rc(tid * 16 + i * 8192, R, C); const int Rb = Epi::PERM ? ((R & ~31) + perm32(R & 31)) : R;
        voffA[i] = (unsigned)(R * K + C) * 2u; voffB[i] = (unsigned)(Rb * K + C) * 2u; }
    const size_t kstep = (size_t)(BK * 2);
    const size_t hstep = (size_t)HALF * K * 2;
    const size_t tstep = 2 * hstep;
    const unsigned ldsw = (unsigned)wid * 1024u;
    const int aoff = lds_byte(wr * 64 + fr, fq * 8), boff = lds_byte(wc * 32 + fr, fq * 8);
#define PG8_SA(b, h) (((b) * 2 + (h)) * HTB)
#define PG8_SB(b, h) ((4 + (b) * 2 + (h)) * HTB)
#define PG8_STAGE(bufoff, gbase, voff) do { _Pragma("unroll") for (int _i = 0; _i < 2; ++_i) \
        __builtin_amdgcn_global_load_lds((const unsigned*)((const char*)(gbase) + (voff)[_i]), (LAS unsigned*)(lds + (bufoff) + ldsw + _i * 8192), 16, 0, 0); } while (0)
#define PG8_LDA(dst, b, h) do { _Pragma("unroll") for (int m = 0; m < 4; ++m) _Pragma("unroll") for (int k = 0; k < 2; ++k) dst[m][k] = *(const LAS bf16x8*)(lds + PG8_SA(b, h) + aoff + m * 2048 + k * 1024); } while (0)
#define PG8_LDB(dst, b, h) do { _Pragma("unroll") for (int n = 0; n < 2; ++n) _Pragma("unroll") for (int k = 0; k < 2; ++k) dst[n][k] = *(const LAS bf16x8*)(lds + PG8_SB(b, h) + boff + n * 2048 + k * 1024); } while (0)
#define PG8_MMA(ai, bj, At, Bt) do { __builtin_amdgcn_s_setprio(1); _Pragma("unroll") for (int m = 0; m < 4; ++m) _Pragma("unroll") for (int n = 0; n < 2; ++n) _Pragma("unroll") for (int k = 0; k < 2; ++k) \
        acc[ai][bj][m][n] = __builtin_amdgcn_mfma_f32_16x16x32_bf16(Bt[n][k], At[m][k], acc[ai][bj][m][n], 0, 0, 0); __builtin_amdgcn_s_setprio(0); } while (0)
#define PG8_WAIT_V(n) asm volatile("s_waitcnt vmcnt(" #n ")" ::: "memory")
#define PG8_WAIT_L(n) asm volatile("s_waitcnt lgkmcnt(" #n ")" ::: "memory")
#define PG8_BAR __builtin_amdgcn_s_barrier()
#define PG8_SCHED __builtin_amdgcn_sched_barrier(0)
    Unit cur, nxt; int ui = 0;
    if (!S.next(0, cur)) return;
    f32x4 acc[2][2][4][2];
#pragma unroll
    for (int a = 0; a < 2; ++a)
#pragma unroll
        for (int b = 0; b < 2; ++b)
#pragma unroll
            for (int m = 0; m < 4; ++m)
#pragma unroll
                for (int n = 0; n < 2; ++n) acc[a][b][m][n] = (f32x4){0.f, 0.f, 0.f, 0.f};
    bf16x8 At[4][2], B0[2][2], B1[2][2];
    const char* cA = (const char*)g.A + (size_t)cur.pm * tstep; const char* cB = (const char*)g.Bt + (size_t)cur.pn * tstep;
    PG8_STAGE(PG8_SB(0, 0), cB, voffB); PG8_STAGE(PG8_SB(0, 1), cB + hstep, voffB); PG8_STAGE(PG8_SA(0, 0), cA, voffA); PG8_STAGE(PG8_SA(0, 1), cA + hstep, voffA);
    if (wr == 1) PG8_BAR;
    PG8_WAIT_V(2); PG8_BAR;
    PG8_STAGE(PG8_SB(1, 0), cB + kstep, voffB); PG8_STAGE(PG8_SA(1, 0), cA + kstep, voffA); PG8_STAGE(PG8_SB(1, 1), cB + hstep + kstep, voffB);
    PG8_WAIT_V(6); PG8_BAR;
    for (;;) {
        const bool has_next = S.next(ui + 1, nxt);
        const char* nA = has_next ? (const char*)g.A + (size_t)nxt.pm * tstep : cA; const char* nB = has_next ? (const char*)g.Bt + (size_t)nxt.pn * tstep : cB;
        for (int t = 0; t < nt; t += 2) {
            const bool last = (t == nt - 2);
            const char* a1 = cA + (size_t)(t + 1) * kstep;
            const char* a2 = last ? nA : cA + (size_t)(t + 2) * kstep; const char* b2 = last ? nB : cB + (size_t)(t + 2) * kstep;
            const char* a3 = a2 + kstep; const char* b3 = b2 + kstep;
            PG8_LDB(B0, 0, 0); PG8_LDB(B1, 0, 1); PG8_SCHED; PG8_LDA(At, 0, 0); PG8_STAGE(PG8_SA(1, 1), a1 + hstep, voffA);
            PG8_WAIT_V(8); PG8_WAIT_L(0); PG8_BAR; PG8_MMA(0, 0, At, B0); PG8_MMA(0, 1, At, B1); PG8_BAR; PG8_SCHED;
            PG8_LDA(At, 0, 1); PG8_STAGE(PG8_SB(0, 0), b2, voffB); PG8_STAGE(PG8_SB(0, 1), b2 + hstep, voffB); PG8_STAGE(PG8_SA(0, 0), a2, voffA);
            PG8_WAIT_V(8); PG8_WAIT_L(0); PG8_BAR; PG8_MMA(1, 0, At, B0); PG8_MMA(1, 1, At, B1); PG8_BAR; PG8_SCHED;
            PG8_LDB(B0, 1, 0); PG8_LDB(B1, 1, 1); PG8_SCHED; PG8_LDA(At, 1, 0); PG8_STAGE(PG8_SA(0, 1), a2 + hstep, voffA);
            PG8_WAIT_V(8); PG8_WAIT_L(0); PG8_BAR; PG8_MMA(0, 0, At, B0); PG8_MMA(0, 1, At, B1); PG8_BAR; PG8_SCHED;
            PG8_LDA(At, 1, 1); PG8_STAGE(PG8_SB(1, 0), b3, voffB); PG8_STAGE(PG8_SB(1, 1), b3 + hstep, voffB); PG8_STAGE(PG8_SA(1, 0), a3, voffA);
            PG8_WAIT_V(8); PG8_WAIT_L(0); PG8_BAR; PG8_MMA(1, 0, At, B0); PG8_MMA(1, 1, At, B1); PG8_BAR; PG8_SCHED;
        }
        if (wr == 0) PG8_BAR;
        E(acc, cur, wr, wc, fr, fq);
        if (!has_next) break;
#pragma unroll
        for (int a = 0; a < 2; ++a)
#pragma unroll
            for (int b = 0; b < 2; ++b)
#pragma unroll
                for (int m = 0; m < 4; ++m)
#pragma unroll
                    for (int n = 0; n < 2; ++n) acc[a][b][m][n] = (f32x4){0.f, 0.f, 0.f, 0.f};
        cur = nxt; cA = nA; cB = nB; ++ui;
        if (wr == 1) PG8_BAR;
    }
    PG8_WAIT_V(0);
    PG8_BAR;
#undef PG8_SA
#undef PG8_SB
#undef PG8_STAGE
#undef PG8_LDA
#undef PG8_LDB
#undef PG8_MMA
#undef PG8_WAIT_V
#undef PG8_WAIT_L
#undef PG8_BAR
#undef PG8_SCHED
}
}

struct Ctx {
    LAS unsigned char* lds;
    int tid, lane, wave, G, bid;
    const Params* p;
};
#define WSP(T, off) ((T*)(P.ws + (off)))

template <bool SWAP>
__device__ __forceinline__ f32x4 tile_mm(const LAS bf16_t* A, int lda, const LAS bf16_t* B, int ldb, int m0, int n0, int ksteps, int fr, int fq) {
    f32x4 acc = (f32x4){0.f, 0.f, 0.f, 0.f};
    for (int ks = 0; ks < ksteps; ++ks) {
        const bf16x8 a = *(const LAS bf16x8*)(A + (m0 + fr) * lda + ks * 32 + fq * 8);
        const bf16x8 b = *(const LAS bf16x8*)(B + (n0 + fr) * ldb + ks * 32 + fq * 8);
        acc = SWAP ? mfma16(b, a, acc) : mfma16(a, b, acc);
    }
    return acc;
}

__device__ __forceinline__ void transpose_item(const float* W, int K, int Nsrc, int c0, bf16_t* WT, int mode, LAS float* scr, int kb, int nb, int lane) {
    const int k0 = 64 * kb, n0 = 32 * nb;
    float tv[32];
#pragma unroll
    for (int i = 0; i < 32; ++i) { const int kk = 2 * i + (lane >> 5); tv[i] = W[(size_t)(k0 + kk) * Nsrc + c0 + n0 + (lane & 31)]; }
#pragma unroll
    for (int i = 0; i < 32; ++i) { const int kk = 2 * i + (lane >> 5); scr[kk * 33 + (lane & 31)] = tv[i]; }
    asm volatile("s_waitcnt lgkmcnt(0)" ::: "memory");
    const int c = lane & 7;
#pragma unroll
    for (int j = 0; j < 4; ++j) { const int n = (lane >> 3) + 8 * j; const LAS float* s = scr + (8 * c) * 33 + n;
        u32x4 o; o.x = pk2(s[0 * 33], s[1 * 33]); o.y = pk2(s[2 * 33], s[3 * 33]); o.z = pk2(s[4 * 33], s[5 * 33]); o.w = pk2(s[6 * 33], s[7 * 33]);
        const int nn = n0 + n; const int row = (mode == 0) ? nn : ((nn >> 7) * 256 + (nn & 127) + (mode == 2 ? 128 : 0));
        *(u32x4*)(WT + (size_t)row * K + k0 + 8 * c) = o; }
    asm volatile("s_waitcnt lgkmcnt(0)" ::: "memory");
}
__device__ __forceinline__ void tr_job(const Ctx& F, int& base, const float* W, int K, int Nsrc, int c0, int ncols, int mode, bf16_t* WT, LAS float* scr, int gw = -1, int NGW = 0) {
    if (gw < 0) { gw = F.bid * 8 + F.wave; NGW = F.G * 8; }
    const int nnb = ncols / 32, items = (K / 64) * nnb;
    const int first = (gw - base % NGW + NGW) % NGW;
    for (int it = first; it < items; it += NGW) transpose_item(W, K, Nsrc, c0, WT, mode, scr, it / nnb, it % nnb, F.lane);
    base += items;
}

__device__ __forceinline__ void s5_precompute(const Ctx& F, int g) {
    const Params& P = *F.p;
    LAS float* AP = (LAS float*)F.lds;
    LAS float* BB = AP + 17 * 128;
    LAS float* CC = BB + 2048;
    LAS float* KD = CC + 2048;
    LAS float* FF = KD + 4096;
    const int tid = F.tid;
    if (tid < 64) {
        const int n = tid; const float lr = P.in[9][g * 64 + n], li = P.in[10][g * 64 + n], dt = expf(P.in[11][g]);
        const float mag = expf(lr * dt); float sn, cs; sincosf(li * dt, &sn, &cs);
        const float ar = mag * cs, ai = mag * sn, den = lr * lr + li * li, nr = ar - 1.0f, ni = ai;
        FF[2 * n] = (nr * lr + ni * li) / den; FF[2 * n + 1] = (ni * lr - nr * li) / den;
        float pr = 1.f, pi = 0.f;
        for (int d = 0; d <= 16; ++d) { AP[(d * 64 + n) * 2] = pr; AP[(d * 64 + n) * 2 + 1] = pi; const float tr = pr * ar - pi * ai, ti = pr * ai + pi * ar; pr = tr; pi = ti; }
        float* A16 = WSP(float, WS_SMALL + SM_A16) + g * 128;
        A16[n] = AP[(16 * 64 + n) * 2]; A16[64 + n] = AP[(16 * 64 + n) * 2 + 1];
    }
    __syncthreads();
    for (int idx = tid; idx < 1024; idx += 512) {
        const int n = idx >> 4, q = idx & 15; const float br = P.in[12][(g * 64 + n) * 16 + q], bi = P.in[13][(g * 64 + n) * 16 + q], fr_ = FF[2 * n], fi_ = FF[2 * n + 1];
        BB[idx * 2] = fr_ * br - fi_ * bi; BB[idx * 2 + 1] = fr_ * bi + fi_ * br;
        const int p = idx >> 6, nn = idx & 63;
        CC[idx * 2] = P.in[14][(g * 16 + p) * 64 + nn]; CC[idx * 2 + 1] = P.in[15][(g * 16 + p) * 64 + nn];
    }
    __syncthreads();
    for (int idx = tid; idx < 4096; idx += 512) {
        const int d = idx >> 8, p = (idx >> 4) & 15, q = idx & 15; float s = 0.f;
        for (int n = 0; n < 64; ++n) { const float cr = CC[(p * 64 + n) * 2], ci = CC[(p * 64 + n) * 2 + 1], ar = AP[(d * 64 + n) * 2], ai = AP[(d * 64 + n) * 2 + 1], br = BB[(n * 16 + q) * 2], bi = BB[(n * 16 + q) * 2 + 1];
            const float zr = cr * ar - ci * ai, zi = cr * ai + ci * ar; s += zr * br - zi * bi; }
        if (d == 0 && p == q) s += P.in[16][g * 16 + p];
        KD[idx] = s;
    }
    __syncthreads();
    bf16_t* KT = WSP(bf16_t, WS_BIG + B_S5KT) + (size_t)g * 256 * 384;
    for (int ch = tid; ch < 256 * 48; ch += 512) {
        const int n = ch / 48, k0 = (ch % 48) * 8, t = n >> 4, p = n & 15; float v[8];
#pragma unroll
        for (int j = 0; j < 8; ++j) { const int k = k0 + j;
            if (k < 256) { const int s = k >> 4, q = k & 15; v[j] = (s <= t) ? KD[((t - s) * 16 + p) * 16 + q] : 0.f; }
            else { const int kk = k - 256, nn = kk & 63; const float cr = CC[(p * 64 + nn) * 2], ci = CC[(p * 64 + nn) * 2 + 1], ar = AP[((t + 1) * 64 + nn) * 2], ai = AP[((t + 1) * 64 + nn) * 2 + 1];
                v[j] = (kk < 64) ? (cr * ar - ci * ai) : -(cr * ai + ci * ar); } }
        u32x4 o; o.x = pk2(v[0], v[1]); o.y = pk2(v[2], v[3]); o.z = pk2(v[4], v[5]); o.w = pk2(v[6], v[7]);
        *(u32x4*)(KT + (size_t)n * 384 + k0) = o;
    }
    bf16_t* WT = WSP(bf16_t, WS_BIG + B_S5WT) + (size_t)g * 128 * 256;
    for (int ch = tid; ch < 128 * 32; ch += 512) {
        const int np = ch / 32, k0 = (ch % 32) * 8, n = np & 63; float v[8];
#pragma unroll
        for (int j = 0; j < 8; ++j) { const int k = k0 + j, s = k >> 4, q = k & 15; const float ar = AP[((15 - s) * 64 + n) * 2], ai = AP[((15 - s) * 64 + n) * 2 + 1], br = BB[(n * 16 + q) * 2], bi = BB[(n * 16 + q) * 2 + 1];
            v[j] = (np < 64) ? (ar * br - ai * bi) : (ar * bi + ai * br); }
        u32x4 o; o.x = pk2(v[0], v[1]); o.y = pk2(v[2], v[3]); o.z = pk2(v[4], v[5]); o.w = pk2(v[6], v[7]);
        *(u32x4*)(WT + (size_t)np * 256 + k0) = o;
    }
    __syncthreads();
}

__device__ __forceinline__ void ada_gemv(const Ctx& F, const LAS float* sc, int layer, int gw, int NGW) {
    const Params& P = *F.p; float* MODP = WSP(float, WS_SMALL + SM_MODP);
    for (int task = gw; task < 192 * 8; task += NGW) {
        const int kp = task & 7, cb = task >> 3;
        const float* W = P.in[layer ? 27 : 2] + (size_t)(kp * 256) * 12288 + cb * 64 + F.lane;
        float acc = 0.f;
#pragma unroll 16
        for (int k = 0; k < 256; ++k) acc += sc[kp * 256 + k] * W[(size_t)k * 12288];
        MODP[(size_t)(kp * 2 + layer) * 12288 + cb * 64 + F.lane] = acc;
    }
}
__device__ __forceinline__ void ada_gemv_layer1_idle(const Ctx& F, int first_idle, int end_idle) {
    const Params& P = *F.p;
    LAS float* sc = (LAS float*)F.lds;
    for (int k = F.tid; k < DM; k += 512) sc[k] = siluf_(P.in[1][k]);
    __syncthreads();
    ada_gemv(F, sc, 1, (F.bid - first_idle) * 8 + F.wave, (end_idle - first_idle) * 8);
    __syncthreads();
    LAS float* scr = (LAS float*)F.lds + F.wave * (64 * 33);
    char* Wb = (char*)WSP(bf16_t, WS_W); int base = 0; const int gw = (F.bid - first_idle) * 8 + F.wave, NGW = (end_idle - first_idle) * 8;
    tr_job(F, base, P.in[23], 2048, 2048, 0, 2048, 0, (bf16_t*)(Wb + W_OUT0), scr, gw, NGW);
    tr_job(F, base, P.in[26], 5632, 2048, 0, 2048, 0, (bf16_t*)(Wb + W_DN0), scr, gw, NGW);
    tr_job(F, base, P.in[33], 2048, 6160, 0, 6144, 0, (bf16_t*)(Wb + W_IN1), scr, gw, NGW);
}
__device__ __forceinline__ void phase_prologue(const Ctx& F) {
    const Params& P = *F.p;
    if (F.bid < 64) s5_precompute(F, F.bid);
    LAS float* sc = (LAS float*)F.lds;
    for (int k = F.tid; k < DM; k += 512) sc[k] = siluf_(P.in[1][k]);
    __syncthreads();
    if (F.bid >= 64) ada_gemv(F, sc, 0, (F.bid - 64) * 8 + F.wave, (F.G - 64) * 8);
    __syncthreads();
    LAS float* scr = (LAS float*)F.lds + F.wave * (64 * 33);
    char* Wb = (char*)WSP(bf16_t, WS_W); int base = 0;
    tr_job(F, base, P.in[8], 2048, 4112, 0, 4096, 0, (bf16_t*)(Wb + W_IN0), scr);
    tr_job(F, base, P.in[17], 1024, 1024, 0, 1024, 0, (bf16_t*)(Wb + W_GLU), scr);
    tr_job(F, base, P.in[24], 2048, 5632, 0, 5632, 1, (bf16_t*)(Wb + W_GU0), scr);
    tr_job(F, base, P.in[25], 2048, 5632, 0, 5632, 2, (bf16_t*)(Wb + W_GU0), scr);
}
__device__ __forceinline__ void convert_layer1_in(const Ctx& F) {
    const Params& P = *F.p;
    LAS float* scr = (LAS float*)F.lds + F.wave * (64 * 33);
    char* Wb = (char*)WSP(bf16_t, WS_W); int base = 0;
    tr_job(F, base, P.in[33], 2048, 6160, 0, 6144, 0, (bf16_t*)(Wb + W_IN1), scr);
}
__device__ __forceinline__ void convert_layer1_rest_idle(const Ctx& F, int first_idle, int end_idle) {
    const Params& P = *F.p;
    LAS float* scr = (LAS float*)F.lds + F.wave * (64 * 33);
    char* Wb = (char*)WSP(bf16_t, WS_W); int base = 0; const int gw = (F.bid - first_idle) * 8 + F.wave, NGW = (end_idle - first_idle) * 8;
    tr_job(F, base, P.in[37], 2048, 2048, 0, 2048, 0, (bf16_t*)(Wb + W_OUT1), scr, gw, NGW);
    tr_job(F, base, P.in[38], 2048, 5632, 0, 5632, 1, (bf16_t*)(Wb + W_GU1), scr, gw, NGW);
    tr_job(F, base, P.in[39], 2048, 5632, 0, 5632, 2, (bf16_t*)(Wb + W_GU1), scr, gw, NGW);
    tr_job(F, base, P.in[40], 5632, 2048, 0, 2048, 0, (bf16_t*)(Wb + W_DN1), scr, gw, NGW);
}

__device__ __forceinline__ float treduce16(float (&t)[16], int lane) {
#pragma unroll
    for (int half = 8, off = 32; half >= 1; half >>= 1, off >>= 1) {
        const bool up = (lane & off) != 0;
#pragma unroll
        for (int i = 0; i < half; ++i) { const float a = t[i], b = t[i + half]; const float send = up ? a : b, keep = up ? b : a; t[i] = keep + __shfl_xor(send, off); }
    }
    float r = t[0]; r += __shfl_xor(r, 2); r += __shfl_xor(r, 1); return r;
}
struct RowCfg;
template <bool POST, bool PRE>
__device__ __forceinline__ void row_core(const Params& P, const RowCfg& c, LAS float* vA, LAS float* vB, LAS float* vP, const bf16_t* RAW, const float* SSQ, bf16_t* H, int row, int lane, f32x4 (&v)[8]);
struct RowCfg { int lpost, gt_off, wpost_in, lpre, wpre_in, sc_off, sh_off, thin_in, thin_nsrc, thin_c0; const float* xsrc; float* thin_out; };
template <bool POST, bool PRE>
__device__ __forceinline__ void row_core(const Params& P, const RowCfg& c, LAS float* vA, LAS float* vB, LAS float* vP, const bf16_t* RAW, const float* SSQ, bf16_t* H, int row, int lane, f32x4 (&v)[8]) {
    const f32x4* xs = (const f32x4*)(c.xsrc + (size_t)row * DM) + lane;
#pragma unroll
    for (int j = 0; j < 8; ++j) v[j] = xs[64 * j];
    if (POST) {
        const u32x2* rs = (const u32x2*)(RAW + (size_t)row * DM) + lane;
        float s = (lane < 32) ? SSQ[(size_t)row * 32 + lane] : 0.f; s = wave_sum(s);
        const float rstd = rsqrtf(s * (1.0f / DM) + EPS);
        f32x4* os = (f32x4*)(P.out + (size_t)row * DM) + lane;
#pragma unroll
        for (int j = 0; j < 8; ++j) { const u32x2 rb = rs[64 * j]; const f32x4 r = (f32x4){__uint_as_float(rb.x << 16), __uint_as_float(rb.x & 0xffff0000u), __uint_as_float(rb.y << 16), __uint_as_float(rb.y & 0xffff0000u)};
            const f32x4 pv = *(const LAS f32x4*)(vP + j * 256 + lane * 4); v[j] += r * rstd * pv; os[64 * j] = v[j]; }
    }
    if (PRE) {
        float s2 = 0.f;
#pragma unroll
        for (int j = 0; j < 8; ++j) s2 += (v[j][0] * v[j][0] + v[j][1] * v[j][1]) + (v[j][2] * v[j][2] + v[j][3] * v[j][3]);
        s2 = wave_sum(s2);
        const float rstd2 = rsqrtf(s2 * (1.0f / DM) + EPS);
        u32x2* hs = (u32x2*)(H + (size_t)row * DM) + lane;
#pragma unroll
        for (int j = 0; j < 8; ++j) { const f32x4 a = *(const LAS f32x4*)(vA + j * 256 + lane * 4), b = *(const LAS f32x4*)(vB + j * 256 + lane * 4);
            v[j] = v[j] * rstd2 * a + b; u32x2 w; w.x = cvt_pk_bf16(v[j][0], v[j][1]); w.y = cvt_pk_bf16(v[j][2], v[j][3]); hs[64 * j] = w; }
    }
}
template <bool POST, bool PRE, bool THIN>
__device__ __forceinline__ void row_phase(const Ctx& F, const RowCfg c) {
    const Params& P = *F.p;
    LAS float* vA = (LAS float*)F.lds; LAS float* vB = vA + 2048; LAS float* vP = vB + 2048; LAS float* tw = vP + 2048;
    const float* MODP = WSP(float, WS_SMALL + SM_MODP);
    const float* adab_post = P.in[c.lpost ? 28 : 3]; const float* adab_pre = P.in[c.lpre ? 28 : 3];
    for (int j = F.tid; j < DM; j += 512) {
        if (POST) { float g = adab_post[c.gt_off + j]; for (int pp = 0; pp < 8; ++pp) g += MODP[(size_t)(pp * 2 + c.lpost) * 12288 + c.gt_off + j]; vP[j] = g * P.in[c.wpost_in][j]; }
        if (PRE) { float s = adab_pre[c.sc_off + j], h = adab_pre[c.sh_off + j];
            for (int pp = 0; pp < 8; ++pp) { s += MODP[(size_t)(pp * 2 + c.lpre) * 12288 + c.sc_off + j]; h += MODP[(size_t)(pp * 2 + c.lpre) * 12288 + c.sh_off + j]; }
            vA[j] = P.in[c.wpre_in][j] * (1.0f + s); vB[j] = h; }
    }
    if (THIN) { const float* W = P.in[c.thin_in]; for (int e = F.tid; e < 16 * 2048; e += 512) { const int k = e >> 4, cc = e & 15; tw[cc * 2048 + k] = W[(size_t)k * c.thin_nsrc + c.thin_c0 + cc]; } }
    __syncthreads();
    const int gw = F.bid * 8 + F.wave, NGW = F.G * 8, lane = F.lane;
    const bf16_t* RAW = WSP(bf16_t, WS_RAW); const float* SSQ = WSP(float, WS_SMALL + SM_SSQ); bf16_t* H = WSP(bf16_t, WS_H);
    if (!THIN) {
        for (int row = gw; row < SEQ; row += NGW) { f32x4 v[8]; row_core<POST, PRE>(P, c, vA, vB, vP, RAW, SSQ, H, row, lane, v); }
    } else {
        for (int row = gw; row < SEQ; row += 2 * NGW) {
            f32x4 v0[8], v1[8];
            const int rowB = row + NGW; const bool hasB = rowB < SEQ;
            row_core<POST, PRE>(P, c, vA, vB, vP, RAW, SSQ, H, row, lane, v0);
            if (hasB) row_core<POST, PRE>(P, c, vA, vB, vP, RAW, SSQ, H, rowB, lane, v1);
            else {
#pragma unroll
                for (int j = 0; j < 8; ++j) v1[j] = (f32x4){0.f, 0.f, 0.f, 0.f}; }
            float t0[16], t1[16];
#pragma unroll
            for (int cc = 0; cc < 16; ++cc) { float a0 = 0.f, a1 = 0.f;
#pragma unroll
                for (int j = 0; j < 8; ++j) { const f32x4 w = *(const LAS f32x4*)(tw + cc * 2048 + j * 256 + lane * 4);
                    a0 += (v0[j][0] * w[0] + v0[j][1] * w[1]) + (v0[j][2] * w[2] + v0[j][3] * w[3]);
                    a1 += (v1[j][0] * w[0] + v1[j][1] * w[1]) + (v1[j][2] * w[2] + v1[j][3] * w[3]); }
                t0[cc] = a0; t1[cc] = a1; }
            const float r0 = treduce16(t0, lane), r1 = treduce16(t1, lane);
            if ((lane & 3) == 0) { c.thin_out[(size_t)row * 16 + ((lane >> 2) & 15)] = r0; if (hasB) c.thin_out[(size_t)rowB * 16 + ((lane >> 2) & 15)] = r1; }
        }
    }
}

__device__ __forceinline__ void s5_wu_phase(const Ctx& F) {
    const Params& P = *F.p;
    const bf16_t* UG = WSP(bf16_t, WS_BIG + B_UG); const bf16_t* WTb = WSP(bf16_t, WS_BIG + B_S5WT); float* WU = WSP(float, WS_BIG + B_S5WU);
    const int gw = F.bid * 8 + F.wave, NGW = F.G * 8, lane = F.lane, fr = lane & 15, fq = lane >> 4;
    for (int task = gw; task < 64 * 64; task += NGW) {
        const int g = task >> 6, c0 = (task & 63) * 16;
        bf16x8 a[8];
#pragma unroll
        for (int ks = 0; ks < 8; ++ks) a[ks] = *(const bf16x8*)(UG + ((size_t)g * SEQ + (size_t)(c0 + fr) * 16) * 16 + ks * 32 + fq * 8);
        const bf16_t* WT = WTb + (size_t)g * 128 * 256;
#pragma unroll 2
        for (int nt = 0; nt < 8; ++nt) {
            f32x4 acc = (f32x4){0.f, 0.f, 0.f, 0.f};
#pragma unroll
            for (int ks = 0; ks < 8; ++ks) { const bf16x8 b = *(const bf16x8*)(WT + (size_t)(nt * 16 + fr) * 256 + ks * 32 + fq * 8); acc = mfma16(b, a[ks], acc); }
            *(f32x4*)(WU + ((size_t)g * 1024 + c0 + fr) * 128 + nt * 16 + fq * 4) = acc;
        }
    }
}
__device__ __forceinline__ float gelu_tanh(float x) { const float z = 0.7978845608028654f * (x + 0.044715f * x * x * x); const float e = __expf(2.0f * z); const float th = 1.0f - 2.0f * __builtin_amdgcn_rcpf(e + 1.0f); return 0.5f * x * (1.0f + th); }
__device__ __forceinline__ void s5_group_phase(const Ctx& F, int g) {
    const Params& P = *F.p;
    const bf16_t* UG = WSP(bf16_t, WS_BIG + B_UG) + (size_t)g * SEQ * 16; const float* WU = WSP(float, WS_BIG + B_S5WU) + (size_t)g * 1024 * 128;
    bf16_t* XC = WSP(bf16_t, WS_BIG + B_S5XC) + (size_t)g * 1024 * 128; const bf16_t* KT = WSP(bf16_t, WS_BIG + B_S5KT) + (size_t)g * 256 * 384;
    bf16_t* YG = WSP(bf16_t, WS_BIG + B_YG);
    const int tid = F.tid, lane = F.lane, fr = lane & 15, fq = lane >> 4;
    {
        LAS float* wu = (LAS float*)F.lds;
        LAS bf16_t* xs = (LAS bf16_t*)(F.lds + 65536);
        const float* A16 = WSP(float, WS_SMALL + SM_A16) + g * 128; const float ar = A16[lane], ai = A16[64 + lane]; float cr = 0.f, ci = 0.f;
        for (int blk = 0; blk < 8; ++blk) {
            f32x4 t[8];
#pragma unroll
            for (int i = 0; i < 8; ++i) t[i] = *(const f32x4*)(WU + (size_t)blk * 16384 + (size_t)(i * 512 + tid) * 4);
#pragma unroll
            for (int i = 0; i < 8; ++i) *(LAS f32x4*)(wu + (i * 512 + tid) * 4) = t[i];
            __syncthreads();
            if (F.wave == 0) {
#pragma unroll 8
                for (int c = 0; c < 128; ++c) { const float wr_ = wu[c * 128 + lane], wi_ = wu[c * 128 + 64 + lane];
                    xs[c * 128 + lane] = (bf16_t)f2bf(cr); xs[c * 128 + 64 + lane] = (bf16_t)f2bf(ci);
                    const float nr = ar * cr - ai * ci + wr_, ni = ar * ci + ai * cr + wi_; cr = nr; ci = ni; }
            }
            __syncthreads();
#pragma unroll
            for (int i = 0; i < 4; ++i) *(u32x4*)(XC + (size_t)blk * 16384 + (size_t)(i * 512 + tid) * 8) = *(const LAS u32x4*)(xs + (i * 512 + tid) * 8);
        }
    }
    __threadfence(); __syncthreads();
    LAS bf16_t* As = (LAS bf16_t*)F.lds;
    bf16x8 bfr[2][12];
#pragma unroll
    for (int t2 = 0; t2 < 2; ++t2)
#pragma unroll
        for (int ks = 0; ks < 12; ++ks) bfr[t2][ks] = *(const bf16x8*)(KT + (size_t)((F.wave * 2 + t2) * 16 + fr) * 384 + ks * 32 + fq * 8);
    u32x4 pu, px; px = (u32x4){0u, 0u, 0u, 0u};
    pu = *(const u32x4*)(UG + (size_t)tid * 8); if (tid < 256) px = *(const u32x4*)(XC + (size_t)tid * 8);
    *(LAS u32x4*)(As + (tid >> 5) * 392 + (tid & 31) * 8) = pu; if (tid < 256) *(LAS u32x4*)(As + (tid >> 4) * 392 + 256 + (tid & 15) * 8) = px;
    __syncthreads();
    for (int mt = 0; mt < 64; ++mt) {
        const int c0 = mt * 16, buf = mt & 1;
        if (mt + 1 < 64) { pu = *(const u32x4*)(UG + (size_t)(c0 + 16) * 256 + (size_t)tid * 8); if (tid < 256) px = *(const u32x4*)(XC + (size_t)(c0 + 16) * 128 + (size_t)tid * 8); }
        bf16x8 a[12];
#pragma unroll
        for (int ks = 0; ks < 12; ++ks) a[ks] = *(const LAS bf16x8*)(As + buf * 6272 + fr * 392 + ks * 32 + fq * 8);
#pragma unroll
        for (int t2 = 0; t2 < 2; ++t2) {
            f32x4 acc = (f32x4){0.f, 0.f, 0.f, 0.f};
#pragma unroll
            for (int ks = 0; ks < 12; ++ks) acc = mfma16(bfr[t2][ks], a[ks], acc);
            const int t = F.wave * 2 + t2;
            u32x2 w; w.x = pk2(gelu_tanh(acc[0]), gelu_tanh(acc[1])); w.y = pk2(gelu_tanh(acc[2]), gelu_tanh(acc[3]));
            *(u32x2*)(YG + (size_t)((c0 + fr) * 16 + t) * 1024 + g * 16 + fq * 4) = w;
        }
        if (mt + 1 < 64) { *(LAS u32x4*)(As + (buf ^ 1) * 6272 + (tid >> 5) * 392 + (tid & 31) * 8) = pu; if (tid < 256) *(LAS u32x4*)(As + (buf ^ 1) * 6272 + (tid >> 4) * 392 + 256 + (tid & 15) * 8) = px; }
        __syncthreads();
    }
}

__device__ __forceinline__ void gdn_local_unit(const Ctx& F, int hv, int n) {
    const Params& P = *F.p;
    LAS unsigned char* lds = F.lds;
    LAS float* tmp = (LAS float*)lds;
    LAS float* Lf = (LAS float*)lds;
    LAS bf16_t* Tb = (LAS bf16_t*)(lds + 16384);
    LAS bf16_t* At = (LAS bf16_t*)(lds + 25600);
    LAS bf16_t* wT = (LAS bf16_t*)(lds + 34816);
    LAS bf16_t* uT = (LAS bf16_t*)(lds + 53248);
    LAS bf16_t* qn = (LAS bf16_t*)(lds + 71680);
    LAS bf16_t* kn = (LAS bf16_t*)(lds + 89088);
    LAS bf16_t* vbT = (LAS bf16_t*)(lds + 106496);
    LAS bf16_t* kbgT = (LAS bf16_t*)(lds + 124928);
    LAS bf16_t* kdT = (LAS bf16_t*)(lds + 143360);
    LAS float* gcs = (LAS float*)(lds + 161792);
    LAS float* bts = gcs + 64;
    const int tid = F.tid, lane = F.lane, w = F.wave, fr = lane & 15, fq = lane >> 4;
    const int hq = hv >> 1, t0 = n * 64, u = hv * 256 + n;
    const bf16_t* Y0 = WSP(bf16_t, WS_BIG + B_Y); const float* AB = WSP(float, WS_SMALL + SM_AB);
    if (tid < 64) {
        const float av = AB[(size_t)(t0 + tid) * 16 + hv], bv = AB[(size_t)(t0 + tid) * 16 + 8 + hv];
        const float xx = av + P.in[21][hv]; const float sp = (xx > 20.f) ? xx : log1pf(expf(xx));
        float gv = -expf(P.in[20][hv]) * sp;
#pragma unroll
        for (int o = 1; o < 64; o <<= 1) { const float t = __shfl_up(gv, o); if (lane >= o) gv += t; }
        gcs[tid] = gv; bts[tid] = sigmoidf_(bv);
        if (tid == 63) WSP(float, WS_SMALL + SM_GG)[u] = expf(gv);
    }
    LBAR();
    if (tid < 384) {
        const int which = tid >> 7, d = tid & 127;
        const int col = (which == 0) ? (1024 + hq * 128 + d) : (which == 1) ? (1536 + hq * 128 + d) : (2048 + hv * 128 + d);
        const int ch = (which == 0) ? (hq * 128 + d) : (which == 1) ? (512 + hq * 128 + d) : (1024 + hv * 128 + d);
        const float* cw = P.in[19]; const float w0 = cw[ch], w1 = cw[2048 + ch], w2 = cw[4096 + ch], w3 = cw[6144 + ch];
        const bf16_t* src = Y0 + col;
        unsigned short xin[67];
#pragma unroll
        for (int i = 0; i < 67; ++i) { const int tt = t0 - 3 + i; const unsigned short xv = src[(size_t)(tt < 0 ? 0 : tt) * 4096]; xin[i] = (tt >= 0) ? xv : (unsigned short)0; }
#pragma unroll
        for (int t = 0; t < 64; ++t) {
            float y = w0 * bf2f(xin[t]) + w1 * bf2f(xin[t + 1]) + w2 * bf2f(xin[t + 2]) + w3 * bf2f(xin[t + 3]); y = siluf_(y);
            if (which < 2) tmp[(which * 64 + t) * 129 + d] = y; else vbT[d * 72 + t] = (bf16_t)f2bf(y * bts[t]);
        }
    }
    LBAR();
    {
        const int which = w >> 2; const float gl = gcs[63];
        for (int rr = 0; rr < 16; ++rr) {
            const int t = (w & 3) * 16 + rr; const float a = tmp[(which * 64 + t) * 129 + lane], b = tmp[(which * 64 + t) * 129 + lane + 64];
            const float ss = wave_sum(a * a + b * b); float rinv = rsqrtf(ss + EPS);
            if (which == 0) { rinv *= 0.08838834764831845f; qn[t * 136 + lane] = (bf16_t)f2bf(a * rinv); qn[t * 136 + lane + 64] = (bf16_t)f2bf(b * rinv); }
            else { const float ka = a * rinv, kb = b * rinv, gt = gcs[t]; const float e1 = bts[t] * __expf(gt), e2 = __expf(gl - gt);
                kn[t * 136 + lane] = (bf16_t)f2bf(ka); kn[t * 136 + lane + 64] = (bf16_t)f2bf(kb);
                kbgT[lane * 72 + t] = (bf16_t)f2bf(ka * e1); kbgT[(lane + 64) * 72 + t] = (bf16_t)f2bf(kb * e1);
                kdT[lane * 72 + t] = (bf16_t)f2bf(ka * e2); kdT[(lane + 64) * 72 + t] = (bf16_t)f2bf(kb * e2); }
        }
    }
    LBAR();
    {
        const int which = w >> 2, mt = w & 3;
        for (int nt = 0; nt < 4; ++nt) {
            const f32x4 acc = tile_mm<false>(which ? qn : kn, 136, kn, 136, mt * 16, nt * 16, 4, fr, fq);
#pragma unroll
            for (int r = 0; r < 4; ++r) { const int i = mt * 16 + fq * 4 + r, j = nt * 16 + fr;
                const float dec = (i >= j) ? __expf(gcs[i] - gcs[j]) : 0.f;
                if (which == 0) Lf[i * 64 + j] = (i > j) ? bts[i] * acc[r] * dec : 0.f;
                else At[i * 72 + j] = (bf16_t)f2bf((i >= j) ? acc[r] * dec : 0.f); }
        }
    }
    LBAR();
    if (w == 0) {
        LAS float* Tf = (LAS float*)(lds + 34816);
        LAS float* Xs = (LAS float*)(lds + 51200);
        {
            const int b = lane >> 4, c = lane & 15; float t[16];
#pragma unroll
            for (int i = 0; i < 16; ++i) {
                float acc = (i == c) ? 1.f : 0.f;
#pragma unroll
                for (int j = 0; j < i; ++j) acc -= Lf[(16 * b + i) * 64 + 16 * b + j] * t[j];
                t[i] = acc;
            }
#pragma unroll
            for (int i = 0; i < 16; ++i) Tf[(16 * b + i) * 64 + 16 * b + c] = t[i];
        }
        const int ri = lane & 15, kk = lane >> 4;
#pragma unroll
        for (int i = 1; i < 4; ++i)
#pragma unroll
            for (int j = 0; j < i; ++j) {
                f32x4 acc = (f32x4){0.f, 0.f, 0.f, 0.f};
#pragma unroll
                for (int k = j; k < i; ++k)
#pragma unroll
                    for (int sq = 0; sq < 4; ++sq) acc = __builtin_amdgcn_mfma_f32_16x16x4f32(Lf[(16 * i + ri) * 64 + 16 * k + 4 * sq + kk], Tf[(16 * k + 4 * sq + kk) * 64 + 16 * j + ri], acc, 0, 0, 0);
#pragma unroll
                for (int r = 0; r < 4; ++r) Xs[(kk * 4 + r) * 16 + ri] = acc[r];
                f32x4 a2 = (f32x4){0.f, 0.f, 0.f, 0.f};
#pragma unroll
                for (int sq = 0; sq < 4; ++sq) a2 = __builtin_amdgcn_mfma_f32_16x16x4f32(Tf[(16 * i + ri) * 64 + 16 * i + 4 * sq + kk], Xs[(4 * sq + kk) * 16 + ri], a2, 0, 0, 0);
#pragma unroll
                for (int r = 0; r < 4; ++r) Tf[(16 * i + kk * 4 + r) * 64 + 16 * j + ri] = -a2[r];
            }
#pragma unroll 8
        for (int i = 0; i < 64; ++i) { const float v = ((i >> 4) >= (lane >> 4)) ? Tf[i * 64 + lane] : 0.f; Tb[i * 72 + lane] = (bf16_t)f2bf(v); }
    }
    LBAR();
    {
        const int which = w >> 2, mt = w & 3;
        for (int nt = 0; nt < 8; ++nt) {
            const f32x4 acc = tile_mm<false>(Tb, 72, which ? kbgT : vbT, 72, mt * 16, nt * 16, 2, fr, fq);
            u32x2 o; o.x = pk2(acc[0], acc[1]); o.y = pk2(acc[2], acc[3]);
            *(LAS u32x2*)((which ? wT : uT) + (nt * 16 + fr) * 72 + mt * 16 + fq * 4) = o;
        }
    }
    LBAR();
    {
        bf16_t* Pg = WSP(bf16_t, WS_H) + (size_t)u * 16384; bf16_t* RTg = WSP(bf16_t, WS_RAW + 64 * MiB) + (size_t)u * 16384;
        bf16_t* QEg = WSP(bf16_t, WS_BIG + B_QE) + (size_t)u * 8192; bf16_t* OUg = WSP(bf16_t, WS_BIG + B_OU) + (size_t)u * 8192;
        for (int tile = w; tile < 192; tile += 8) {
            if (tile < 64) { const int mt = tile >> 3, nt = tile & 7; const f32x4 acc = tile_mm<true>(kdT, 72, wT, 72, mt * 16, nt * 16, 2, fr, fq);
                u32x2 o; o.x = pk2(acc[0], acc[1]); o.y = pk2(acc[2], acc[3]);
                *(u32x2*)(Pg + (((mt * 4 + (nt >> 1)) * 64 + ((nt & 1) * 2 + (fq >> 1)) * 16 + fr) * 8 + (fq & 1) * 4)) = o; }
            else if (tile < 128) { const int tt = tile - 64, mt = tt >> 3, nt = tt & 7; const f32x4 acc = tile_mm<true>(uT, 72, kdT, 72, mt * 16, nt * 16, 2, fr, fq);
                u32x2 o; o.x = pk2(acc[0], acc[1]); o.y = pk2(acc[2], acc[3]); *(u32x2*)(RTg + ((mt * 8 + nt) * 64 + lane) * 4) = o; }
            else if (tile < 160) { const int tt = tile - 128, mt = tt >> 3, nt = tt & 7; const f32x4 acc = tile_mm<true>(At, 72, wT, 72, mt * 16, nt * 16, 2, fr, fq);
                const int i = mt * 16 + fr; const float eg = __expf(gcs[i]); float q[4];
#pragma unroll
                for (int r = 0; r < 4; ++r) q[r] = bf2f(qn[i * 136 + nt * 16 + fq * 4 + r]) * eg - acc[r];
                u32x2 o; o.x = pk2(q[0], q[1]); o.y = pk2(q[2], q[3]);
                *(u32x2*)(QEg + (((mt * 4 + (nt >> 1)) * 64 + ((nt & 1) * 2 + (fq >> 1)) * 16 + fr) * 8 + (fq & 1) * 4)) = o; }
            else { const int tt = tile - 160, mt = tt >> 3, nt = tt & 7; const f32x4 acc = tile_mm<true>(At, 72, uT, 72, mt * 16, nt * 16, 2, fr, fq);
                u32x2 o; o.x = pk2(acc[0], acc[1]); o.y = pk2(acc[2], acc[3]); *(u32x2*)(OUg + ((nt * 4 + mt) * 64 + lane) * 4) = o; }
        }
    }
    LBAR();
}

struct GS { bf16x8 pf[4], qf[4]; u32x2 rt, ou; float gl; };
__device__ __forceinline__ void gs_load(GS& x, const bf16_t* Pg, const bf16_t* RTg, const bf16_t* QEg, const bf16_t* OUg, const float* GG, int hv, int n, int w, int fr, int fq, int dv0) {
    const size_t u = (size_t)hv * 256 + n;
#pragma unroll
    for (int ks = 0; ks < 4; ++ks) x.pf[ks] = *(const bf16x8*)(Pg + u * 16384 + ((w * 4 + ks) * 64 + fq * 16 + fr) * 8);
    x.rt = *(const u32x2*)(RTg + u * 16384 + (((dv0 >> 4) * 8 + w) * 64 + fq * 16 + fr) * 4);
    x.gl = GG[u];
    if (w < 4) {
#pragma unroll
        for (int ks = 0; ks < 4; ++ks) x.qf[ks] = *(const bf16x8*)(QEg + u * 8192 + ((w * 4 + ks) * 64 + fq * 16 + fr) * 8);
        x.ou = *(const u32x2*)(OUg + u * 8192 + (((dv0 >> 4) * 4 + w) * 64 + fq * 16 + fr) * 4);
    }
}
__device__ __forceinline__ void gdn_scan_wg(const Ctx& F, int hv, int sl) {
    const Params& P = *F.p;
    LAS bf16_t* Sb = (LAS bf16_t*)F.lds;
    const int lane = F.lane, w = F.wave, fr = lane & 15, fq = lane >> 4, dv0 = sl * 16;
    const bf16_t* Pg = WSP(bf16_t, WS_H); const bf16_t* RTg = WSP(bf16_t, WS_RAW + 64 * MiB);
    const bf16_t* QEg = WSP(bf16_t, WS_BIG + B_QE); const bf16_t* OUg = WSP(bf16_t, WS_BIG + B_OU);
    const float* GG = WSP(float, WS_SMALL + SM_GG); bf16_t* O = WSP(bf16_t, WS_RAW);
    for (int e = F.tid; e < 2 * 16 * 136; e += 512) Sb[e] = 0;
    f32x4 s = (f32x4){0.f, 0.f, 0.f, 0.f};
    int* prog = WSP(int, WS_SMALL + SM_PROG) + hv * 64; const bool publish = (sl == 0);
    constexpr int RS = 4;
    GS ring[RS];
#pragma unroll
    for (int i = 0; i < RS - 1; ++i) gs_load(ring[i], Pg, RTg, QEg, OUg, GG, hv, i, w, fr, fq, dv0);
    asm volatile("s_waitcnt lgkmcnt(0)" ::: "memory"); __builtin_amdgcn_s_barrier(); asm volatile("" ::: "memory");
    for (int n0 = 0; n0 < 256; n0 += 4 * RS) {
#pragma unroll
        for (int j = 0; j < 4 * RS; ++j) {
            const int n = n0 + j;
            if (n < 256) {
            const int cur = n & 1;
            { const int nn = (n + RS - 1 < 256) ? n + RS - 1 : 255; gs_load(ring[(j + RS - 1) % RS], Pg, RTg, QEg, OUg, GG, hv, nn, w, fr, fq, dv0); }
            const GS& x = ring[j % RS];
            if (publish && F.tid == 0) __hip_atomic_store(prog, n, __ATOMIC_RELAXED, __HIP_MEMORY_SCOPE_AGENT);
            bf16x8 sf[4];
#pragma unroll
            for (int ks = 0; ks < 4; ++ks) sf[ks] = *(const LAS bf16x8*)(Sb + cur * 2176 + fr * 136 + ks * 32 + fq * 8);
            f32x4 pacc = (f32x4){0.f, 0.f, 0.f, 0.f};
#pragma unroll
            for (int ks = 0; ks < 4; ++ks) pacc = mfma16(x.pf[ks], sf[ks], pacc);
            if (w < 4) {
                f32x4 oacc = (f32x4){__uint_as_float(x.ou.x << 16), __uint_as_float(x.ou.x & 0xffff0000u), __uint_as_float(x.ou.y << 16), __uint_as_float(x.ou.y & 0xffff0000u)};
#pragma unroll
                for (int ks = 0; ks < 4; ++ks) oacc = mfma16(sf[ks], x.qf[ks], oacc);
                { u32x2 ob; ob.x = pk2(oacc[0], oacc[1]); ob.y = pk2(oacc[2], oacc[3]); *(u32x2*)(O + ((size_t)(hv * 8 + (dv0 >> 4)) * SEQ + (n * 64 + w * 16 + fr)) * 16 + fq * 4) = ob; }
            }
            const f32x4 rv = (f32x4){__uint_as_float(x.rt.x << 16), __uint_as_float(x.rt.x & 0xffff0000u), __uint_as_float(x.rt.y << 16), __uint_as_float(x.rt.y & 0xffff0000u)};
            s = s * x.gl + rv - pacc;
            u32x2 o; o.x = pk2(s[0], s[1]); o.y = pk2(s[2], s[3]);
            *(LAS u32x2*)(Sb + (cur ^ 1) * 2176 + fr * 136 + w * 16 + fq * 4) = o;
            asm volatile("s_waitcnt lgkmcnt(0)" ::: "memory"); __builtin_amdgcn_s_barrier(); asm volatile("" ::: "memory");
            }
        }
    }
    asm volatile("s_waitcnt vmcnt(0)" ::: "memory");
}
__device__ __forceinline__ void gdn_warm_wg(const Ctx& F, int hv, int wi) {
    const Params& P = *F.p;
    const char* Pg = (const char*)WSP(bf16_t, WS_H); const char* RTg = (const char*)WSP(bf16_t, WS_RAW + 64 * MiB);
    const char* QEg = (const char*)WSP(bf16_t, WS_BIG + B_QE); const char* OUg = (const char*)WSP(bf16_t, WS_BIG + B_OU);
    int* prog = WSP(int, WS_SMALL + SM_PROG) + hv * 64;
    unsigned sum = 0;
    for (int n = F.wave; n < 256; n += 8) {
        int spins = 0;
        while (true) { const int p = __hip_atomic_load(prog, __ATOMIC_RELAXED, __HIP_MEMORY_SCOPE_AGENT); if (p + 12 >= n || ++spins > 4000) break; __builtin_amdgcn_s_sleep(16); }
        const size_t u = (size_t)hv * 256 + n;
#pragma unroll
        for (int i = 0; i < 3; ++i) { const int li = wi * 192 + i * 64 + F.lane;
            const char* a = (li < 256) ? (Pg + u * 32768 + (size_t)li * 128) : (li < 512) ? (RTg + u * 32768 + (size_t)(li - 256) * 128) : (li < 640) ? (QEg + u * 16384 + (size_t)(li - 512) * 128) : (OUg + u * 16384 + (size_t)(li - 640) * 128);
            sum += *(const volatile unsigned*)a; }
    }
    if (sum == 0x9e3779b9u) prog[32] = (int)sum;
}
__device__ __forceinline__ void gdn_finalize(const Ctx& F) {
    const Params& P = *F.p;
    const bf16_t* O = WSP(bf16_t, WS_RAW); const bf16_t* Y0 = WSP(bf16_t, WS_BIG + B_Y); bf16_t* CAT = WSP(bf16_t, WS_CAT);
    const int gw = F.bid * 8 + F.wave, NGW = F.G * 8, lane = F.lane, d0 = (lane & 7) * 16;
    float nw[16];
#pragma unroll
    for (int i = 0; i < 16; ++i) nw[i] = P.in[22][d0 + i];
    for (int row = gw; row < SEQ; row += NGW) {
        float o[16]; const u32x4* op = (const u32x4*)(O + ((size_t)lane * SEQ + row) * 16);
        float ss = 0.f;
        { const u32x4 a = op[0], b = op[1]; const unsigned ww[8] = {a.x, a.y, a.z, a.w, b.x, b.y, b.z, b.w};
#pragma unroll
          for (int i = 0; i < 8; ++i) { o[2 * i] = __uint_as_float(ww[i] << 16); o[2 * i + 1] = __uint_as_float(ww[i] & 0xffff0000u); ss += o[2 * i] * o[2 * i] + o[2 * i + 1] * o[2 * i + 1]; } }
        ss += __shfl_xor(ss, 1); ss += __shfl_xor(ss, 2); ss += __shfl_xor(ss, 4);
        const float rstd = rsqrtf(ss * (1.0f / 128.0f) + EPS);
        const u32x4* zp = (const u32x4*)(Y0 + (size_t)row * 4096 + 3072 + lane * 16); unsigned zz[8];
        { const u32x4 a = zp[0], b = zp[1]; zz[0] = a.x; zz[1] = a.y; zz[2] = a.z; zz[3] = a.w; zz[4] = b.x; zz[5] = b.y; zz[6] = b.z; zz[7] = b.w; }
        unsigned ov[8];
#pragma unroll
        for (int i = 0; i < 8; ++i) { const float z0 = __uint_as_float(zz[i] << 16), z1 = __uint_as_float(zz[i] & 0xffff0000u);
            ov[i] = pk2(o[2 * i] * rstd * nw[2 * i] * siluf_(z0), o[2 * i + 1] * rstd * nw[2 * i + 1] * siluf_(z1)); }
        u32x4* cp = (u32x4*)(CAT + (size_t)row * 2048 + 1024 + lane * 16);
        cp[0] = (u32x4){ov[0], ov[1], ov[2], ov[3]}; cp[1] = (u32x4){ov[4], ov[5], ov[6], ov[7]};
    }
}

__device__ __forceinline__ void gla_local_unit(const Ctx& F, int h, int n) {
    const Params& P = *F.p;
    LAS float* bc = (LAS float*)F.lds;
    LAS bf16_t* qt = (LAS bf16_t*)(F.lds + 65536);
    LAS bf16_t* kt = (LAS bf16_t*)(F.lds + 99328);
    LAS float* gl = (LAS float*)(F.lds + 133120);
    const int tid = F.tid, lane = F.lane, w = F.wave, fr = lane & 15, fq = lane >> 4, t0 = n * 64, u = h * 256 + n;
    const bf16_t* Y1 = WSP(bf16_t, WS_BIG + B_Y); const float* GLOW = WSP(float, WS_SMALL + SM_GLOW);
    bf16_t* QT = WSP(bf16_t, WS_H) + (size_t)u * 16384; bf16_t* KDT = WSP(bf16_t, WS_H + 32 * MiB) + (size_t)u * 16384;
    bf16_t* ATT = WSP(bf16_t, WS_BIG + B_ATT) + (size_t)u * 4096; bf16_t* VT = WSP(bf16_t, WS_BIG + B_VT) + (size_t)u * 32768;
    float* GLAST = WSP(float, WS_SMALL + SM_GLAST);
    for (int e = tid; e < 1024; e += 512) gl[e] = GLOW[(size_t)t0 * 16 + e];
    LBAR();
    if (tid < 256) {
        const int dk = tid, col = h * 256 + dk; float w2[16];
#pragma unroll
        for (int j = 0; j < 16; ++j) w2[j] = P.in[34][j * 1024 + col];
        const float gb = P.in[35][col]; float run = 0.f;
        for (int t = 0; t < 64; ++t) { float x = gb;
#pragma unroll
            for (int j = 0; j < 16; ++j) x += gl[t * 16 + j] * w2[j];
            const float ls = fminf(x, 0.f) - __logf(1.0f + __expf(-fabsf(x)));
            run += ls * 0.0625f; bc[t * 256 + dk] = run; }
    } else {
        for (int rep = 0; rep < 2; ++rep) { const int dv = (tid - 256) + rep * 256; const bf16_t* src = Y1 + (size_t)t0 * 6144 + 2048 + h * 512 + dv;
            unsigned short x[64];
#pragma unroll
            for (int j = 0; j < 64; ++j) x[j] = src[(size_t)j * 6144];
#pragma unroll
            for (int c0 = 0; c0 < 64; c0 += 8) {
                u32x4 o; o.x = x[c0] | ((unsigned)x[c0 + 1] << 16); o.y = x[c0 + 2] | ((unsigned)x[c0 + 3] << 16); o.z = x[c0 + 4] | ((unsigned)x[c0 + 5] << 16); o.w = x[c0 + 6] | ((unsigned)x[c0 + 7] << 16);
                *(u32x4*)(VT + ((((dv >> 4) * 2 + (c0 >> 5)) * 64 + ((c0 >> 3) & 3) * 16 + (dv & 15)) * 8)) = o; } }
    }
    LBAR();
    for (int item = tid; item < 2048; item += 512) {
        const int dk = item & 255, tb = item >> 8; const float bl = bc[63 * 256 + dk]; float kd[8]; unsigned short qr[8], kr[8];
#pragma unroll
        for (int j = 0; j < 8; ++j) { const int t = tb * 8 + j; qr[j] = Y1[(size_t)(t0 + t) * 6144 + h * 256 + dk]; kr[j] = Y1[(size_t)(t0 + t) * 6144 + 1024 + h * 256 + dk]; }
#pragma unroll
        for (int j = 0; j < 8; ++j) { const int t = tb * 8 + j; const float b = bc[t * 256 + dk];
            const float q = bf2f(qr[j]) * 0.0625f, k = bf2f(kr[j]);
            qt[t * 264 + dk] = (bf16_t)f2bf(q * __expf(b));
            kt[t * 264 + dk] = (bf16_t)f2bf(k * __expf(-b)); kd[j] = k * __expf(bl - b); }
        u32x4 o; o.x = pk2(kd[0], kd[1]); o.y = pk2(kd[2], kd[3]); o.z = pk2(kd[4], kd[5]); o.w = pk2(kd[6], kd[7]);
        *(u32x4*)(KDT + ((((dk >> 4) * 2 + (tb >> 2)) * 64 + (tb & 3) * 16 + (dk & 15)) * 8)) = o;
        if (tb == 7) GLAST[(size_t)n * 1024 + h * 256 + dk] = __expf(bl);
    }
    LBAR();
    for (int t2 = 0; t2 < 2; ++t2) { const int tile = w * 2 + t2, mt = tile >> 2, nt = tile & 3;
        const f32x4 acc = tile_mm<true>(qt, 264, kt, 264, mt * 16, nt * 16, 8, fr, fq);
        const int i = mt * 16 + fr; float a[4];
#pragma unroll
        for (int r = 0; r < 4; ++r) { const int j = nt * 16 + fq * 4 + r; a[r] = (j <= i) ? acc[r] : 0.f; }
        u32x2 o; o.x = pk2(a[0], a[1]); o.y = pk2(a[2], a[3]); *(u32x2*)(ATT + (((mt * 2 + (nt >> 1)) * 64 + ((nt & 1) * 2 + (fq >> 1)) * 16 + fr) * 8 + (fq & 1) * 4)) = o; }
    for (int piece = tid; piece < 2048; piece += 512) { const int w_ = piece >> 8, mt = (piece >> 6) & 3, ln = piece & 63, fr_ = ln & 15, fq_ = ln >> 4;
        const LAS bf16_t* qp = qt + (mt * 16 + fr_) * 264 + w_ * 32 + fq_ * 4; const u32x2 lo = *(const LAS u32x2*)qp, hi = *(const LAS u32x2*)(qp + 16);
        *(u32x4*)(QT + (size_t)piece * 8) = (u32x4){lo.x, lo.y, hi.x, hi.y}; }
    LBAR();
}
struct LS { bf16x8 qf[4], kf[2][2], vf[2], af[2]; f32x4 g0, g1; };
__device__ __forceinline__ void ls_load(LS& x, const bf16_t* QT, const bf16_t* KDTb, const bf16_t* ATTb, const bf16_t* VTb, const float* GLAST, int h, int n, int w, int fr, int fq, int dv0, int dk0) {
    const size_t u = (size_t)h * 256 + n; const int lane = fq * 16 + fr;
#pragma unroll
    for (int mt = 0; mt < 4; ++mt) x.qf[mt] = *(const bf16x8*)(QT + u * 16384 + ((w * 4 + mt) * 64 + lane) * 8);
#pragma unroll
    for (int tl = 0; tl < 2; ++tl)
#pragma unroll
        for (int ks = 0; ks < 2; ++ks) x.kf[tl][ks] = *(const bf16x8*)(KDTb + u * 16384 + (((2 * w + tl) * 2 + ks) * 64 + lane) * 8);
#pragma unroll
    for (int ks = 0; ks < 2; ++ks) x.vf[ks] = *(const bf16x8*)(VTb + u * 32768 + (((dv0 >> 4) * 2 + ks) * 64 + lane) * 8);
    x.g0 = *(const f32x4*)(GLAST + (size_t)n * 1024 + h * 256 + dk0 + fq * 4); x.g1 = *(const f32x4*)(GLAST + (size_t)n * 1024 + h * 256 + dk0 + 16 + fq * 4);
    if (w < 4) {
#pragma unroll
        for (int ks = 0; ks < 2; ++ks) x.af[ks] = *(const bf16x8*)(ATTb + u * 4096 + ((w * 2 + ks) * 64 + lane) * 8);
    }
}
__device__ __forceinline__ void gla_scan_wg(const Ctx& F, int h, int sl) {
    const Params& P = *F.p;
    LAS float* OP = (LAS float*)F.lds;
    const int tid = F.tid, lane = F.lane, w = F.wave, fr = lane & 15, fq = lane >> 4, dv0 = sl * 16, dk0 = w * 32;
    const bf16_t* QT = WSP(bf16_t, WS_H); const bf16_t* KDTb = WSP(bf16_t, WS_H + 32 * MiB);
    const bf16_t* ATTb = WSP(bf16_t, WS_BIG + B_ATT); const bf16_t* VTb = WSP(bf16_t, WS_BIG + B_VT);
    const float* GLAST = WSP(float, WS_SMALL + SM_GLAST); bf16_t* O = WSP(bf16_t, WS_RAW);
    f32x4 s0 = (f32x4){0.f, 0.f, 0.f, 0.f}, s1 = s0;
    int* prog = WSP(int, WS_SMALL + SM_PROG) + (8 + (F.bid & 7)) * 64; const bool publish = (sl < 2);
    LS ring[3];
    ls_load(ring[0], QT, KDTb, ATTb, VTb, GLAST, h, 0, w, fr, fq, dv0, dk0);
    ls_load(ring[1], QT, KDTb, ATTb, VTb, GLAST, h, 1, w, fr, fq, dv0, dk0);
    for (int n0 = 0; n0 < 256; n0 += 12) {
#pragma unroll
        for (int j = 0; j < 12; ++j) {
            const int n = n0 + j;
            if (n < 256) {
                const int t0 = n * 64, buf = n & 1;
                { const int nn = (n + 2 < 256) ? n + 2 : 255; ls_load(ring[(j + 2) % 3], QT, KDTb, ATTb, VTb, GLAST, h, nn, w, fr, fq, dv0, dk0); }
                const LS& x = ring[j % 3];
                if (publish && tid == 0) __hip_atomic_store(prog, n, __ATOMIC_RELAXED, __HIP_MEMORY_SCOPE_AGENT);
                u32x4 sp; sp.x = pk2(s0[0], s0[1]); sp.y = pk2(s0[2], s0[3]); sp.z = pk2(s1[0], s1[1]); sp.w = pk2(s1[2], s1[3]);
                const bf16x8 sf = __builtin_bit_cast(bf16x8, sp);
                f32x4 op[4];
#pragma unroll
                for (int mt = 0; mt < 4; ++mt) op[mt] = mfma16(sf, x.qf[mt], (f32x4){0.f, 0.f, 0.f, 0.f});
                if (w < 4) {
                    f32x4 oi = (f32x4){0.f, 0.f, 0.f, 0.f};
#pragma unroll
                    for (int ks = 0; ks < 2; ++ks) oi = mfma16(x.vf[ks], x.af[ks], oi);
#pragma unroll
                    for (int mt = 0; mt < 4; ++mt) if (mt == w) op[mt] += oi;
                }
#pragma unroll
                for (int mt = 0; mt < 4; ++mt) *(LAS f32x4*)(OP + ((buf * 8 + w) * 64 + mt * 16 + fr) * 16 + fq * 4) = op[mt];
                f32x4 u0 = (f32x4){0.f, 0.f, 0.f, 0.f}, u1 = u0;
#pragma unroll
                for (int ks = 0; ks < 2; ++ks) { u0 = mfma16(x.kf[0][ks], x.vf[ks], u0); u1 = mfma16(x.kf[1][ks], x.vf[ks], u1); }
                s0 = s0 * x.g0 + u0; s1 = s1 * x.g1 + u1;
                asm volatile("s_waitcnt lgkmcnt(0)" ::: "memory"); __builtin_amdgcn_s_barrier(); asm volatile("" ::: "memory");
                { const int e = tid * 2; float a = 0.f, b = 0.f;
#pragma unroll
                    for (int ww = 0; ww < 8; ++ww) { const f32x2 xx = *(const LAS f32x2*)(OP + (buf * 8 + ww) * 1024 + e); a += xx[0]; b += xx[1]; }
                    *(unsigned*)(O + ((size_t)(h * 32 + (dv0 >> 4)) * SEQ + t0) * 16 + e) = pk2(a, b); }
            }
        }
    }
    asm volatile("s_waitcnt vmcnt(0)" ::: "memory");
}
__device__ __forceinline__ void gla_warm_wg(const Ctx& F, int xcd, int wi) {
    const Params& P = *F.p;
    const int h = xcd & 3;
    const char* QT = (const char*)WSP(bf16_t, WS_H); const char* KDTb = (const char*)WSP(bf16_t, WS_H + 32 * MiB);
    const char* ATTb = (const char*)WSP(bf16_t, WS_BIG + B_ATT); const char* VTb = (const char*)WSP(bf16_t, WS_BIG + B_VT);
    int* prog = WSP(int, WS_SMALL + SM_PROG) + (8 + xcd) * 64;
    unsigned sum = 0;
    for (int n = F.wave; n < 256; n += 8) {
        int spins = 0;
        while (true) { const int p = __hip_atomic_load(prog, __ATOMIC_RELAXED, __HIP_MEMORY_SCOPE_AGENT); if (p + 12 >= n || ++spins > 4000) break; __builtin_amdgcn_s_sleep(16); }
        const size_t u = (size_t)h * 256 + n;
#pragma unroll
        for (int i = 0; i < 5; ++i) { const int li = wi * 272 + i * 64 + F.lane;
            if (i * 64 + F.lane < 272) {
                const char* a = (li < 256) ? (QT + u * 32768 + (size_t)li * 128) : (li < 512) ? (KDTb + u * 32768 + (size_t)(li - 256) * 128) : (li < 576) ? (ATTb + u * 8192 + (size_t)(li - 512) * 128) : (VTb + u * 65536 + (size_t)(li - 576) * 128);
                sum += *(const volatile unsigned*)a; } }
    }
    if (sum == 0x9e3779b9u) prog[32] = (int)sum;
}
__device__ __forceinline__ void gla_finalize(const Ctx& F) {
    const Params& P = *F.p;
    const bf16_t* O = WSP(bf16_t, WS_RAW); const bf16_t* Y1 = WSP(bf16_t, WS_BIG + B_Y); bf16_t* CAT = WSP(bf16_t, WS_CAT);
    const int gw = F.bid * 8 + F.wave, NGW = F.G * 8, lane = F.lane, d0 = (lane & 15) * 32;
    for (int row = gw; row < SEQ; row += NGW) {
        f32x4 o[8]; const u32x4* op0 = (const u32x4*)(O + ((size_t)(lane * 2) * SEQ + row) * 16); const u32x4* op1 = (const u32x4*)(O + ((size_t)(lane * 2 + 1) * SEQ + row) * 16); float ss = 0.f;
        const u32x4 ob[4] = {op0[0], op0[1], op1[0], op1[1]};
#pragma unroll
        for (int i = 0; i < 8; ++i) { const u32x4 q4 = ob[i >> 1]; const unsigned w0 = (i & 1) ? q4.z : q4.x, w1 = (i & 1) ? q4.w : q4.y;
            o[i] = (f32x4){__uint_as_float(w0 << 16), __uint_as_float(w0 & 0xffff0000u), __uint_as_float(w1 << 16), __uint_as_float(w1 & 0xffff0000u)}; ss += (o[i][0] * o[i][0] + o[i][1] * o[i][1]) + (o[i][2] * o[i][2] + o[i][3] * o[i][3]); }
        ss += __shfl_xor(ss, 1); ss += __shfl_xor(ss, 2); ss += __shfl_xor(ss, 4); ss += __shfl_xor(ss, 8);
        const float rstd = rsqrtf(ss * (1.0f / 512.0f) + EPS);
        const u32x4* rp = (const u32x4*)(Y1 + (size_t)row * 6144 + 4096 + lane * 32); u32x4* cp = (u32x4*)(CAT + (size_t)row * 2048 + lane * 32);
#pragma unroll
        for (int i = 0; i < 4; ++i) { const u32x4 rv = rp[i]; const unsigned rr[4] = {rv.x, rv.y, rv.z, rv.w}; unsigned ov[4];
#pragma unroll
            for (int j = 0; j < 4; ++j) { const int e = i * 8 + j * 2; const float r0 = __uint_as_float(rr[j] << 16), r1 = __uint_as_float(rr[j] & 0xffff0000u);
                const float x0 = o[e >> 2][e & 3], x1 = o[(e + 1) >> 2][(e + 1) & 3];
                ov[j] = pk2(x0 * rstd * P.in[36][d0 + e] * siluf_(r0), x1 * rstd * P.in[36][d0 + e + 1] * siluf_(r1)); }
            cp[i] = (u32x4){ov[0], ov[1], ov[2], ov[3]}; }
    }
}

#define XB_TMO      128
#define XB_XCNT(j)  (256  + 64 * (j))
#define XB_XSUB(j)  (1280 + 64 * (j))
#define XB_XGEN(j)  (2304 + 64 * (j))
#define XB_TOP      3328
#define XB_TOPGEN   3392
#define XCD_BAR_WORDS 3456
#define XB_SPIN_CAP (1u << 18)
__device__ __forceinline__ unsigned xb_ld(unsigned* p)              { return __hip_atomic_load(p, __ATOMIC_RELAXED, __HIP_MEMORY_SCOPE_AGENT); }
__device__ __forceinline__ unsigned xb_add(unsigned* p, unsigned v) { return __hip_atomic_fetch_add(p, v, __ATOMIC_RELAXED, __HIP_MEMORY_SCOPE_AGENT); }
__device__ __forceinline__ unsigned xb_xcc_id() { return (unsigned)__builtin_amdgcn_s_getreg((3 << 11) | 20) & 0xFu; }
#define XB_SPIN(cond, bar) do { unsigned _sp = 0; while (cond) { __builtin_amdgcn_s_sleep(1); \
    if ((++_sp & 255u) == 0u) { if (xb_ld(&(bar)[XB_TMO])) break; if (_sp > XB_SPIN_CAP) { atomicAdd(&(bar)[XB_TMO], 1u); break; } } } } while (0)
struct XcdBarrier { unsigned* bar; unsigned x; volatile LAS unsigned* st; };
__device__ __forceinline__ XcdBarrier xcd_barrier_post(unsigned* bar, volatile LAS unsigned* st) {
    XcdBarrier b; b.bar = bar; b.x = xb_xcc_id(); b.st = st;
    if (threadIdx.x == 0) (void)xb_add(&bar[XB_XCNT(b.x)], 1u);
    return b;
}
__device__ __forceinline__ void xcd_barrier_complete(unsigned* bar, unsigned x, unsigned& nloc, unsigned& nx) {
    const unsigned G = gridDim.x * gridDim.y * gridDim.z;
    unsigned sum, cnt, mine, sp = 0u;
    for (;;) {
        sum = 0u; cnt = 0u; mine = 0u;
#pragma unroll
        for (unsigned j = 0; j < 16; ++j) { const unsigned c = xb_ld(&bar[XB_XCNT(j)]); sum += c; cnt += (c > 0u) ? 1u : 0u; mine = (j == x) ? c : mine; }
        if (sum == G) break;
        __builtin_amdgcn_s_sleep(1);
        if ((++sp & 255u) == 0u) { if (xb_ld(&bar[XB_TMO])) break; if (sp > XB_SPIN_CAP) { atomicAdd(&bar[XB_TMO], 1u); break; } }
    }
    nloc = mine > 0u ? mine : 1u; nx = cnt > 0u ? cnt : 1u;
}
__device__ __forceinline__ void xcd_barrier(const XcdBarrier& b) {
    asm volatile("s_waitcnt vmcnt(0)" ::: "memory");
    __syncthreads();
    if (threadIdx.x == 0) {
        unsigned* bar = b.bar;
        __builtin_amdgcn_s_waitcnt(0);
        unsigned nloc = b.st[0], nx = b.st[1];
        if (nloc == 0u) { xcd_barrier_complete(bar, b.x, nloc, nx); b.st[0] = nloc; b.st[1] = nx; }
        const unsigned old = xb_add(&bar[XB_XSUB(b.x)], 1u);
        const unsigned gen = old / nloc;
        if (old + 1u == (gen + 1u) * nloc) {
            __builtin_amdgcn_fence(__ATOMIC_RELEASE, "agent");
            asm volatile("s_waitcnt vmcnt(0)" ::: "memory");
            const unsigned og = xb_add(&bar[XB_TOP], 1u);
            const unsigned tg = og / nx;
            if (og + 1u == (tg + 1u) * nx) xb_add(&bar[XB_TOPGEN], 1u);
            else XB_SPIN(xb_ld(&bar[XB_TOPGEN]) == tg, bar);
            __builtin_amdgcn_fence(__ATOMIC_ACQUIRE, "agent");
            xb_add(&bar[XB_XGEN(b.x)], 1u);
            asm volatile("s_waitcnt vmcnt(0)" ::: "memory");
        } else {
            XB_SPIN(xb_ld(&bar[XB_XGEN(b.x)]) == gen, bar);
            __builtin_amdgcn_fence(__ATOMIC_ACQUIRE, "agent");
            asm volatile("s_waitcnt vmcnt(0)" ::: "memory");
        }
    }
    __syncthreads();
}

__global__ void __launch_bounds__(512, 2) fwd_megakernel(Params prm) {
    extern __shared__ __attribute__((aligned(16))) unsigned char lds_raw[];
    Ctx F; F.lds = (LAS unsigned char*)lds_raw; F.tid = threadIdx.x; F.lane = F.tid & 63; F.wave = __builtin_amdgcn_readfirstlane(F.tid >> 6); F.G = gridDim.x; F.bid = blockIdx.x; F.p = &prm;
    const Params& P = prm;
    const int lo = P.ph_lo, hi = P.ph_hi;
    volatile LAS unsigned* xst = (volatile LAS unsigned*)(F.lds + (LDS_BYTES - 16));
    XcdBarrier xb; xb.bar = WSP(unsigned, WS_SMALL + SM_XBAR); xb.x = 0; xb.st = xst;
    if (hi - lo > 1) { if (F.tid < 4) xst[F.tid] = 0u; __syncthreads(); xb = xcd_barrier_post(WSP(unsigned, WS_SMALL + SM_XBAR), xst); }
    if (hi > 1000) cg::this_grid().sync();
    bf16_t* Wb = WSP(bf16_t, WS_W);
#define WPTR(off) ((const bf16_t*)((const char*)Wb + (off)))
#define PHASE(k) if (lo <= (k) && (k) < hi)
#define SEAM(k) if (lo <= (k) && (k) + 1 < hi) { xcd_barrier(xb); }
    PHASE(0) { phase_prologue(F); } SEAM(0)
    PHASE(1) { RowCfg c{0, 0, 0, 0, 4, 2048, 0, 8, 4112, 4096, P.in[0], WSP(float, WS_SMALL + SM_AB)}; row_phase<false, true, true>(F, c); } SEAM(1)
    PHASE(2) { pg8::Gemm g{WSP(bf16_t, WS_H), WPTR(W_IN0), SEQ, 4096, 2048}; pg8::StaticOrder S; S.init(SEQ, 4096, F.G, F.bid); pg8::EpiIn0 E{WSP(bf16_t, WS_BIG + B_Y), 4096, WSP(bf16_t, WS_BIG + B_UG)}; pg8::gemm_phase(F.lds, g, S, E); } SEAM(2)
    PHASE(3) { if (F.bid == 0 && F.tid < 8) WSP(int, WS_SMALL + SM_PROG)[F.tid * 64] = 0; for (int un = F.bid; un < 2048; un += F.G) gdn_local_unit(F, un & 7, un >> 3); s5_wu_phase(F); } SEAM(3)
    PHASE(4) { if (F.bid < 64) { if (P.mode4 != 2) gdn_scan_wg(F, F.bid & 7, F.bid >> 3); } else if (F.bid < 128) { if (P.mode4 != 1) s5_group_phase(F, F.bid - 64); } else if (F.bid < 224) { if (P.mode4 != 2) ada_gemv_layer1_idle(F, 128, 224); } else gdn_warm_wg(F, F.bid & 7, (F.bid - 224) >> 3); } SEAM(4)
    PHASE(5) { pg8::Gemm g{WSP(bf16_t, WS_BIG + B_YG), WPTR(W_GLU), SEQ, 1024, 1024}; pg8::StaticOrder S; S.init(SEQ, 1024, F.G, F.bid);
               pg8::EpiGlu E{WSP(bf16_t, WS_CAT), 2048, WSP(bf16_t, WS_BIG + B_YG), 1024, P.in[18]}; pg8::gemm_phase(F.lds, g, S, E); gdn_finalize(F); } SEAM(5)
    PHASE(6) { pg8::Gemm g{WSP(bf16_t, WS_CAT), WPTR(W_OUT0), SEQ, 2048, 2048}; pg8::StaticOrder S; S.init(SEQ, 2048, F.G, F.bid); pg8::EpiRaw E{WSP(bf16_t, WS_RAW), 2048, WSP(float, WS_SMALL + SM_SSQ)}; pg8::gemm_phase(F.lds, g, S, E); } SEAM(6)
    PHASE(7) { RowCfg c{0, 4096, 5, 0, 6, 8192, 6144, 0, 0, 0, P.in[0], nullptr}; row_phase<true, true, false>(F, c); } SEAM(7)
    PHASE(8) { pg8::Gemm g{WSP(bf16_t, WS_H), WPTR(W_GU0), SEQ, 11264, 2048}; pg8::StaticOrder S; S.init(SEQ, 11264, F.G, F.bid); pg8::EpiSwiglu E{WSP(bf16_t, WS_BIG + B_HID), FFH}; pg8::gemm_phase(F.lds, g, S, E); } SEAM(8)
    PHASE(9) { pg8::Gemm g{WSP(bf16_t, WS_BIG + B_HID), WPTR(W_DN0), SEQ, 2048, FFH}; pg8::StaticOrder S; S.init(SEQ, 2048, F.G, F.bid); pg8::EpiRaw E{WSP(bf16_t, WS_RAW), 2048, WSP(float, WS_SMALL + SM_SSQ)}; pg8::gemm_phase(F.lds, g, S, E); } SEAM(9)
    PHASE(10) { RowCfg c{0, 10240, 7, 1, 29, 2048, 0, 33, 6160, 6144, P.out, WSP(float, WS_SMALL + SM_GLOW)};
                row_phase<true, true, true>(F, c); } SEAM(10)
    PHASE(11) { pg8::Gemm g{WSP(bf16_t, WS_H), WPTR(W_IN1), SEQ, 6144, 2048}; pg8::StaticOrder S; S.init(SEQ, 6144, F.G, F.bid); pg8::EpiBf16Store E{WSP(bf16_t, WS_BIG + B_Y), 6144}; pg8::gemm_phase(F.lds, g, S, E); } SEAM(11)
    PHASE(12) { if (F.bid == 0 && F.tid < 8) WSP(int, WS_SMALL + SM_PROG)[(8 + F.tid) * 64] = 0; for (int un = F.bid; un < 1024; un += F.G) gla_local_unit(F, un & 3, un >> 2); } SEAM(12)
    PHASE(13) { if (F.bid < 128) gla_scan_wg(F, F.bid & 3, F.bid >> 2); else if (F.bid < 224) convert_layer1_rest_idle(F, 128, 224); else gla_warm_wg(F, F.bid & 7, (F.bid - 224) >> 3); } SEAM(13)
    PHASE(14) { gla_finalize(F); } SEAM(14)
    PHASE(15) { pg8::Gemm g{WSP(bf16_t, WS_CAT), WPTR(W_OUT1), SEQ, 2048, 2048}; pg8::StaticOrder S; S.init(SEQ, 2048, F.G, F.bid); pg8::EpiRaw E{WSP(bf16_t, WS_RAW), 2048, WSP(float, WS_SMALL + SM_SSQ)}; pg8::gemm_phase(F.lds, g, S, E); } SEAM(15)
    PHASE(16) { RowCfg c{1, 4096, 30, 1, 31, 8192, 6144, 0, 0, 0, P.out, nullptr}; row_phase<true, true, false>(F, c); } SEAM(16)
    PHASE(17) { pg8::Gemm g{WSP(bf16_t, WS_H), WPTR(W_GU1), SEQ, 11264, 2048}; pg8::StaticOrder S; S.init(SEQ, 11264, F.G, F.bid); pg8::EpiSwiglu E{WSP(bf16_t, WS_BIG + B_HID), FFH}; pg8::gemm_phase(F.lds, g, S, E); } SEAM(17)
    PHASE(18) { pg8::Gemm g{WSP(bf16_t, WS_BIG + B_HID), WPTR(W_DN1), SEQ, 2048, FFH}; pg8::StaticOrder S; S.init(SEQ, 2048, F.G, F.bid); pg8::EpiRaw E{WSP(bf16_t, WS_RAW), 2048, WSP(float, WS_SMALL + SM_SSQ)}; pg8::gemm_phase(F.lds, g, S, E); } SEAM(18)
    PHASE(19) { RowCfg c{1, 10240, 32, 1, 0, 0, 0, 0, 0, 0, P.out, nullptr}; row_phase<true, false, false>(F, c); }
}

extern "C" void kernel_launch(void* const* d_in, const int* in_sizes, int n_in, void* d_out, int out_size, void* d_ws, size_t ws_size, hipStream_t stream) {
    static int grid = 0;
    if (grid == 0) {
        if (n_in != 41 || ws_size < WS_END) { fprintf(stderr, "kernel_launch: unexpected n_in %d / ws_size %zu (need %zu)\n", n_in, ws_size, (size_t)WS_END); grid = -1; return; }
        int dev = 0, cus = 0, per_cu = 0;
        hipGetDevice(&dev); hipDeviceGetAttribute(&cus, hipDeviceAttributeMultiprocessorCount, dev);
        if (hipFuncSetAttribute((const void*)fwd_megakernel, hipFuncAttributeMaxDynamicSharedMemorySize, LDS_BYTES) != hipSuccess) { fprintf(stderr, "kernel_launch: hipFuncSetAttribute failed\n"); grid = -1; return; }
        hipOccupancyMaxActiveBlocksPerMultiprocessor(&per_cu, (const void*)fwd_megakernel, 512, LDS_BYTES);
        (void)hipGetLastError();
        if (per_cu < 1) per_cu = 1;
        grid = cus * 1;
        fprintf(stderr, "kernel_launch: cus %d per_cu %d grid %d ws %zu\n", cus, per_cu, grid, ws_size);
    }
    if (grid < 0) return;
    Params p{};
    for (int i = 0; i < 41; ++i) p.in[i] = (const float*)d_in[i];
    p.out = (float*)d_out; p.ws = (unsigned char*)d_ws;
#if MK_SINGLE_LAUNCH
    p.ph_lo = 0; p.ph_hi = NPHASE;
    (void)hipMemsetAsync((char*)d_ws + WS_SMALL + SM_XBAR, 0, 3456 * 4, stream);
    void* args[] = {&p};
    hipError_t e = hipLaunchCooperativeKernel((const void*)fwd_megakernel, dim3(grid), dim3(512), args, LDS_BYTES, stream);
    if (e != hipSuccess) fprintf(stderr, "cooperative launch failed: %s (grid %d)\n", hipGetErrorString(e), grid);
#else
    static const int HREP[NPHASE] = {1,1,1,1,1, 1,1,1,1,1, 1,1,1,1,1, 1,1,1,1,1};
    static const int M4[4] = {M4LIST};
    for (int ph = 0; ph < NPHASE; ++ph) for (int r = 0; r < HREP[ph]; ++r) {
        p.ph_lo = ph; p.ph_hi = ph + 1; p.mode4 = (ph == 4) ? M4[r] : 0;
        hipLaunchKernelGGL(fwd_megakernel, dim3(grid), dim3(512), LDS_BYTES, stream, p);
    }
#endif
}
```
